# Optimizing an MI355X kernel written in HIP

```python
import math
import jax
import jax.numpy as jnp
from jax import lax
import numpy as np

D_MODEL = 1024
BATCH = 4
SEQ = 4096
DEPTH = 2

CHUNK = 64
QBLK = 128
HEAD_DIM = 64
NORM_EPS = 1e-6

A_HEADS = 4
A_QK_WIDTH = A_HEADS * 2 * HEAD_DIM
A_VDIM = 2 * HEAD_DIM
A_WIDTH = A_HEADS * A_VDIM

B_HEADS = 8
B_WIDTH = B_HEADS * HEAD_DIM

C_HEADS = 8
C_KV_HEADS = 2
C_GROUP = C_HEADS // C_KV_HEADS
C_WIDTH = C_HEADS * HEAD_DIM
C_KV_WIDTH = C_KV_HEADS * HEAD_DIM
WINDOW = 128
WIN_CHUNKS = WINDOW // CHUNK

D_HEADS = 8
D_WIDTH = D_HEADS * HEAD_DIM
D_LEFT_CHUNKS = 8
D_BAND = (D_LEFT_CHUNKS + 1) * CHUNK
REL_MAX = 256
REL_SIZE = REL_MAX + CHUNK

EVEN_SPLITS = (A_QK_WIDTH, A_QK_WIDTH, A_WIDTH, A_WIDTH, B_WIDTH, B_WIDTH, B_WIDTH, B_WIDTH, B_HEADS)
ODD_SPLITS = (C_WIDTH, C_KV_WIDTH, C_KV_WIDTH, C_WIDTH, D_WIDTH, D_WIDTH, D_WIDTH, D_WIDTH)
P_EVEN = sum(EVEN_SPLITS)
P_ODD = sum(ODD_SPLITS)
MIX_EVEN = A_WIDTH + B_WIDTH
MIX_ODD = C_WIDTH + D_WIDTH

kernel_name = "hybrid_chunk_causal_attn_trunk"


def rms_norm(x, g):
    xf = x.astype(jnp.float32)
    y = xf * lax.rsqrt(jnp.mean(xf * xf, axis=-1, keepdims=True) + NORM_EPS)
    return (y * g.astype(jnp.float32)).astype(x.dtype)


def split_cols(z, sizes):
    idx = np.cumsum(np.array(sizes))[:-1].tolist()
    return jnp.split(z, idx, axis=-1)


def alibi_slopes(n_heads):
    return 2.0 ** (-8.0 * jnp.arange(1, n_heads + 1, dtype=jnp.float32) / n_heads)


def sweep_query_blocks(fn, n_blocks):
    out = lax.map(fn, jnp.arange(n_blocks))
    out = jnp.moveaxis(out, 0, 1)
    return out.reshape((out.shape[0], -1) + out.shape[3:])


def diff_attention(q, k, v, lam, lam_init, subln_g):
    bsz, seq = q.shape[:2]
    scale = HEAD_DIM ** -0.5
    slopes = alibi_slopes(A_HEADS)
    tk = jnp.arange(seq)

    def block(b):
        start = b * QBLK
        tq = start + jnp.arange(QBLK)
        qb = lax.dynamic_slice_in_dim(q, start, QBLK, axis=1)
        s = jnp.einsum("bqhcd,bkhcd->bhcqk", qb, k).astype(jnp.float32) * scale
        dist = jnp.abs(tq[:, None] - tk[None, :]).astype(jnp.float32)
        s = s - (slopes[:, None, None] * dist)[None, :, None]
        allowed = (tk[None, :] // CHUNK) <= (tq[:, None] // CHUNK)
        s = jnp.where(allowed, s, -jnp.inf)
        p = jax.nn.softmax(s, axis=-1)
        w = p[:, :, 0] - lam * p[:, :, 1]
        return jnp.einsum("bhqk,bkhe->bqhe", w.astype(v.dtype), v)

    o = sweep_query_blocks(block, seq // QBLK)
    o = rms_norm(o, subln_g) * (1.0 - lam_init)
    return o.reshape(bsz, seq, A_WIDTH)


def forgetting_attention(q, k, v, log_f):
    bsz, seq = q.shape[:2]
    scale = HEAD_DIM ** -0.5
    cum = jnp.transpose(jnp.cumsum(log_f, axis=1), (0, 2, 1))
    tk = jnp.arange(seq)

    def block(b):
        start = b * QBLK
        tq = start + jnp.arange(QBLK)
        qb = lax.dynamic_slice_in_dim(q, start, QBLK, axis=1)
        cq = lax.dynamic_slice_in_dim(cum, start, QBLK, axis=2)
        s = jnp.einsum("bqhd,bkhd->bhqk", qb, k).astype(jnp.float32) * scale
        s = s + cq[..., :, None] - cum[:, :, None, :]
        s = jnp.where(tk[None, :] <= tq[:, None], s, -jnp.inf)
        p = jax.nn.softmax(s, axis=-1)
        return jnp.einsum("bhqk,bkhd->bqhd", p.astype(v.dtype), v)

    o = sweep_query_blocks(block, seq // QBLK)
    return o.reshape(bsz, seq, B_WIDTH)


def sliding_window_sink_attention(q, k, v, sinks):
    bsz, seq = q.shape[:2]
    nb = seq // QBLK
    scale = HEAD_DIM ** -0.5

    def band(t):
        tp = jnp.pad(t, ((0, 0), (QBLK, 0), (0, 0), (0, 0)))
        tb = tp.reshape(bsz, nb + 1, QBLK, C_KV_HEADS, HEAD_DIM)
        return jnp.concatenate([tb[:, :-1], tb[:, 1:]], axis=2)

    kb, vb = band(k), band(v)
    qb = q.reshape(bsz, nb, QBLK, C_KV_HEADS, C_GROUP, HEAD_DIM)
    s = jnp.einsum("bnqkgd,bnskd->bnkgqs", qb, kb).astype(jnp.float32) * scale
    iq = jnp.arange(QBLK)
    ik = jnp.arange(2 * QBLK) - QBLK
    dist = jnp.abs(iq[:, None] - ik[None, :]).astype(jnp.float32)
    slopes = alibi_slopes(C_HEADS).reshape(C_KV_HEADS, C_GROUP, 1, 1)
    s = s - (slopes * dist)[None, None]
    chunk_diff = (iq[:, None] // CHUNK + QBLK // CHUNK) - ((ik[None, :] + QBLK) // CHUNK)
    in_window = (chunk_diff >= 0) & (chunk_diff <= WIN_CHUNKS)
    valid = (jnp.arange(nb)[:, None] * QBLK + ik[None, :]) >= 0
    mask = in_window[None] & valid[:, None, :]
    s = jnp.where(mask[None, :, None, None], s, -jnp.inf)
    sink = jnp.broadcast_to(sinks.astype(jnp.float32).reshape(1, 1, C_KV_HEADS, C_GROUP, 1, 1),
                            s.shape[:-1] + (1,))
    p = jax.nn.softmax(jnp.concatenate([s, sink], axis=-1), axis=-1)[..., :-1]
    o = jnp.einsum("bnkgqs,bnskd->bnqkgd", p.astype(v.dtype), vb)
    return o.reshape(bsz, seq, C_WIDTH)


def chunk_relpos_attention(q, k, v, rel_table):
    bsz, seq = q.shape[:2]
    nc = seq // CHUNK
    scale = HEAD_DIM ** -0.5
    idx = jnp.arange(nc)[:, None] + jnp.arange(D_LEFT_CHUNKS + 1)[None, :]

    def band(t):
        tp = jnp.pad(t, ((0, 0), (D_LEFT_CHUNKS * CHUNK, 0), (0, 0), (0, 0)))
        tp = tp.reshape(bsz, nc + D_LEFT_CHUNKS, CHUNK, D_HEADS, HEAD_DIM)
        return tp[:, idx].reshape(bsz, nc, D_BAND, D_HEADS, HEAD_DIM)

    kb, vb = band(k), band(v)
    qc = q.reshape(bsz, nc, CHUNK, D_HEADS, HEAD_DIM)
    s = jnp.einsum("bnqhd,bnkhd->bnhqk", qc, kb).astype(jnp.float32) * scale
    iq = jnp.arange(CHUNK)
    ik = jnp.arange(D_BAND) - D_LEFT_CHUNKS * CHUNK
    rel = iq[:, None] - ik[None, :]
    ridx = jnp.clip(rel, -(CHUNK - 1), REL_MAX) + (CHUNK - 1)
    bias = rel_table[:, ridx].astype(jnp.float32)
    s = s + bias[None, None]
    valid = (jnp.arange(nc)[:, None] * CHUNK + ik[None, :]) >= 0
    s = jnp.where(valid[None, :, None, None, :], s, -jnp.inf)
    p = jax.nn.softmax(s, axis=-1)
    o = jnp.einsum("bnhqk,bnkhd->bnqhd", p.astype(v.dtype), vb)
    return o.reshape(bsz, seq, D_WIDTH)


def even_layer(x, ln_g, w_in, w_out, a_qn_g, a_kn_g, a_lq1, a_lk1, a_lq2, a_lk2, a_subln_g,
               b_qn_g, b_kn_g, b_f_bias, layer_idx):
    bsz, seq, _ = x.shape
    z = rms_norm(x, ln_g) @ w_in
    aq, ak, av, ag, bq, bk, bv, bg, bf = split_cols(z, EVEN_SPLITS)
    aq = rms_norm(aq.reshape(bsz, seq, A_HEADS, 2, HEAD_DIM), a_qn_g)
    ak = rms_norm(ak.reshape(bsz, seq, A_HEADS, 2, HEAD_DIM), a_kn_g)
    av = av.reshape(bsz, seq, A_HEADS, A_VDIM)
    lam_init = 0.8 - 0.6 * math.exp(-0.3 * layer_idx)
    f32 = jnp.float32
    lam = (jnp.exp(jnp.sum(a_lq1.astype(f32) * a_lk1.astype(f32)))
           - jnp.exp(jnp.sum(a_lq2.astype(f32) * a_lk2.astype(f32))) + lam_init)
    a_out = diff_attention(aq, ak, av, lam, lam_init, a_subln_g)
    bq = rms_norm(bq.reshape(bsz, seq, B_HEADS, HEAD_DIM), b_qn_g)
    bk = rms_norm(bk.reshape(bsz, seq, B_HEADS, HEAD_DIM), b_kn_g)
    bv = bv.reshape(bsz, seq, B_HEADS, HEAD_DIM)
    log_f = jax.nn.log_sigmoid(bf.astype(f32) + b_f_bias.astype(f32))
    b_out = forgetting_attention(bq, bk, bv, log_f)
    mixed = jnp.concatenate([a_out * jax.nn.silu(ag), b_out * jax.nn.silu(bg)], axis=-1)
    return x + mixed @ w_out


def odd_layer(x, ln_g, w_in, w_out, c_qn_g, c_kn_g, c_sinks, d_qn_g, d_kn_g, d_rel_bias):
    bsz, seq, _ = x.shape
    z = rms_norm(x, ln_g) @ w_in
    cq, ck, cv, cg, dq, dk, dv, dg = split_cols(z, ODD_SPLITS)
    cq = rms_norm(cq.reshape(bsz, seq, C_HEADS, HEAD_DIM), c_qn_g)
    ck = rms_norm(ck.reshape(bsz, seq, C_KV_HEADS, HEAD_DIM), c_kn_g)
    cv = cv.reshape(bsz, seq, C_KV_HEADS, HEAD_DIM)
    c_out = sliding_window_sink_attention(cq, ck, cv, c_sinks)
    dq = rms_norm(dq.reshape(bsz, seq, D_HEADS, HEAD_DIM), d_qn_g)
    dk = rms_norm(dk.reshape(bsz, seq, D_HEADS, HEAD_DIM), d_kn_g)
    dv = dv.reshape(bsz, seq, D_HEADS, HEAD_DIM)
    d_out = chunk_relpos_attention(dq, dk, dv, d_rel_bias)
    mixed = jnp.concatenate([c_out * jax.nn.silu(cg), d_out * jax.nn.silu(dg)], axis=-1)
    return x + mixed @ w_out


def setup_inputs(seed: int = 0) -> dict:
    key = jax.random.key(seed)
    ne = (DEPTH + 1) // 2
    no = DEPTH // 2
    ks = jax.random.split(key, 23)

    def nrm(k, shape, s):
        return s * jax.random.normal(k, shape, jnp.float32)

    def gain(k, shape):
        return 1.0 + 0.1 * jax.random.normal(k, shape, jnp.float32)

    return {
        "x": jax.random.normal(ks[0], (BATCH, SEQ, D_MODEL), jnp.float32),
        "even_ln_g": gain(ks[1], (ne, D_MODEL)),
        "even_w_in": nrm(ks[2], (ne, D_MODEL, P_EVEN), D_MODEL ** -0.5),
        "even_w_out": nrm(ks[3], (ne, MIX_EVEN, D_MODEL), MIX_EVEN ** -0.5),
        "a_q_norm_g": gain(ks[4], (ne, HEAD_DIM)),
        "a_k_norm_g": gain(ks[5], (ne, HEAD_DIM)),
        "a_lambda_q1": nrm(ks[6], (ne, HEAD_DIM), 0.1),
        "a_lambda_k1": nrm(ks[7], (ne, HEAD_DIM), 0.1),
        "a_lambda_q2": nrm(ks[8], (ne, HEAD_DIM), 0.1),
        "a_lambda_k2": nrm(ks[9], (ne, HEAD_DIM), 0.1),
        "a_subln_g": gain(ks[10], (ne, A_VDIM)),
        "b_q_norm_g": gain(ks[11], (ne, HEAD_DIM)),
        "b_k_norm_g": gain(ks[12], (ne, HEAD_DIM)),
        "b_forget_bias": 3.0 + nrm(ks[13], (ne, B_HEADS), 0.5),
        "odd_ln_g": gain(ks[14], (no, D_MODEL)),
        "odd_w_in": nrm(ks[15], (no, D_MODEL, P_ODD), D_MODEL ** -0.5),
        "odd_w_out": nrm(ks[16], (no, MIX_ODD, D_MODEL), MIX_ODD ** -0.5),
        "c_q_norm_g": gain(ks[17], (no, HEAD_DIM)),
        "c_k_norm_g": gain(ks[18], (no, HEAD_DIM)),
        "c_sinks": nrm(ks[19], (no, C_HEADS), 0.5),
        "d_q_norm_g": gain(ks[20], (no, HEAD_DIM)),
        "d_k_norm_g": gain(ks[21], (no, HEAD_DIM)),
        "d_rel_bias": nrm(ks[22], (no, D_HEADS, REL_SIZE), 0.5),
    }


def reference(x, even_ln_g, even_w_in, even_w_out, a_q_norm_g, a_k_norm_g, a_lambda_q1,
              a_lambda_k1, a_lambda_q2, a_lambda_k2, a_subln_g, b_q_norm_g, b_k_norm_g,
              b_forget_bias, odd_ln_g, odd_w_in, odd_w_out, c_q_norm_g, c_k_norm_g, c_sinks,
              d_q_norm_g, d_k_norm_g, d_rel_bias):
    for i in range(DEPTH):
        j = i // 2
        if i % 2 == 0:
            x = even_layer(x, even_ln_g[j], even_w_in[j], even_w_out[j], a_q_norm_g[j],
                           a_k_norm_g[j], a_lambda_q1[j], a_lambda_k1[j], a_lambda_q2[j],
                           a_lambda_k2[j], a_subln_g[j], b_q_norm_g[j], b_k_norm_g[j],
                           b_forget_bias[j], i)
        else:
            x = odd_layer(x, odd_ln_g[j], odd_w_in[j], odd_w_out[j], c_q_norm_g[j],
                          c_k_norm_g[j], c_sinks[j], d_q_norm_g[j], d_k_norm_g[j],
                          d_rel_bias[j])
    return x
```

```cpp
#include <hip/hip_runtime.h>
#include <hip/hip_cooperative_groups.h>
#include <cstdio>
#include <cstdint>
namespace cg = cooperative_groups;
#ifndef PROBE_REP0
#define PROBE_REP0 0
#endif
#ifndef PROBE_REP3
#define PROBE_REP3 0
#endif
#ifndef PROBE_REP4
#define PROBE_REP4 0
#endif
#ifndef PROBE_REP1
#define PROBE_REP1 0
#endif
#ifndef PROBE_REP2
#define PROBE_REP2 0
#endif
#ifndef PROBE_REP5
#define PROBE_REP5 0
#endif
#ifndef MK_LAUNCHES
#define MK_LAUNCHES 1
#endif
namespace pg8 {
#define PG8_LAS __attribute__((address_space(3)))
typedef unsigned short bf16_t;
typedef short bf16x8 __attribute__((ext_vector_type(8)));
typedef float f32x4 __attribute__((ext_vector_type(4)));
typedef unsigned u32x4 __attribute__((ext_vector_type(4)));
constexpr int BM = 256, BK = 64, HALF = 128, HTB = HALF * BK * 2  , STAGE_BYTES = 8 * HTB, NXCD = 8, WGM = 8;

__host__ __device__ __forceinline__ int lds_byte(int r, int c) { const int st = (r >> 4) * 2 + (c >> 5), rr = r & 15, cc = c & 31, ob = rr * 64 + cc * 2; return st * 1024 + (ob ^ (((ob >> 9) & 1) << 5)); }
__host__ __device__ __forceinline__ void stage_rc(int b, int& R, int& C) { const int st = b / 1024, sb = b % 1024, swz = sb ^ (((sb >> 9) & 1) << 5); R = (st >> 1) * 16 + swz / 64; C = (st & 1) * 32 + (swz % 64) / 2; }
__host__ __device__ __forceinline__ int perm32(int rho) { const int n = rho >> 4, i = rho & 15; return 8 * (i >> 2) + 4 * n + (i & 3); }

struct Unit { int pm, pn; };
struct Gemm { const bf16_t* A; const bf16_t* Bt; int M, N, K; };

struct StaticOrder {
    int nM, nN, nwg, G, c;
    __host__ __device__ void init(int M, int N, int G_, int c_) { nM = M / BM; nN = N / BM; nwg = nM * nN; G = G_; c = c_; }
    __host__ __device__ bool next(int i, Unit& u) const {
        const long L = (long)i * G + c; if (L >= nwg) return false;
        int wgid = (int)L; { const int q = nwg / NXCD, r = nwg % NXCD, xcd = wgid % NXCD, off = wgid / NXCD; wgid = (xcd < r ? xcd * (q + 1) : r * (q + 1) + (xcd - r) * q) + off; }
        const int nig = WGM * nN, gid = wgid / nig, fm = gid * WGM, gsz = (nM - fm) < WGM ? (nM - fm) : WGM;
        u.pm = fm + ((wgid % nig) % gsz); u.pn = (wgid % nig) / gsz; return true;
    }
    __device__ __forceinline__ void a_ready(const Unit&) const {}
    __device__ __forceinline__ void done(const Unit&) const {}
};

__device__ __forceinline__ unsigned cvt_pk_bf16(float lo, float hi) { unsigned r; asm volatile("v_cvt_pk_bf16_f32 %0, %1, %2" : "=v"(r) : "v"(lo), "v"(hi)); return r; }
typedef float f32x2 __attribute__((ext_vector_type(2)));
typedef unsigned u32x2 __attribute__((ext_vector_type(2)));
constexpr float QK_C2 = 0.125f * 1.4426950408889634f;
struct EpiIn {
    static constexpr bool PERM = true, AFTER_DRAIN = false;
    bf16_t* O; int ldc; const float* rs; const float* ssq;
    int seg_end[8]; int seg_mode[8]; const float* seg_g[8];
    int pn_off, sw_a, sw_b;
    __device__ __forceinline__ void operator()(const f32x4 (&acc)[2][2][4][2], const Unit& u, int wr, int wc, int fr, int fq) const {
        int lt = u.pn + pn_off; lt = (lt == sw_a) ? sw_b : (lt == sw_b ? sw_a : lt);
        const int gidx = lt * 4 + wc;
        int mode = 0; const float* g = nullptr;
#pragma unroll
        for (int s = 7; s >= 0; --s) if (gidx < seg_end[s]) { mode = seg_mode[s]; g = seg_g[s]; }
        f32x4 gv[2][2];
#pragma unroll
        for (int bj = 0; bj < 2; ++bj)
#pragma unroll
            for (int n = 0; n < 2; ++n) gv[bj][n] = (mode == 1 || mode == 2) ? *(const f32x4*)(g + 32 * bj + 8 * fq + 4 * n) : (f32x4){1.f, 1.f, 1.f, 1.f};
        const float qs = (mode == 1) ? QK_C2 : 1.0f;
        float rr[2][4];
        if (rs) {
#pragma unroll
            for (int ai = 0; ai < 2; ++ai)
#pragma unroll
                for (int m = 0; m < 4; ++m) rr[ai][m] = rs[u.pm * BM + ai * HALF + wr * 64 + m * 16 + fr];
        }
        asm volatile("" ::: "memory");
#pragma unroll
        for (int ai = 0; ai < 2; ++ai) {
            if (!rs) {
                f32x4 sp[4][4];
#pragma unroll
                for (int m = 0; m < 4; ++m) { const f32x4* p_ = (const f32x4*)(ssq + (size_t)(u.pm * BM + ai * HALF + wr * 64 + m * 16 + fr) * 16);
#pragma unroll
                    for (int q = 0; q < 4; ++q) sp[m][q] = p_[q]; }
                asm volatile("" ::: "memory");
#pragma unroll
                for (int m = 0; m < 4; ++m) { const f32x4 a = sp[m][0], b = sp[m][1], c = sp[m][2], d = sp[m][3];
                    const float t = ((a[0] + a[1]) + (a[2] + a[3])) + ((b[0] + b[1]) + (b[2] + b[3])) + ((c[0] + c[1]) + (c[2] + c[3])) + ((d[0] + d[1]) + (d[2] + d[3]));
                    rr[ai][m] = __builtin_amdgcn_rsqf(t * (1.0f / 1024.0f) + 1e-6f); }
            }
#pragma unroll
            for (int m = 0; m < 4; ++m) {
                const int row = u.pm * BM + ai * HALF + wr * 64 + m * 16 + fr;
                const float r = rr[ai][m];
                f32x4 v[2][2];
#pragma unroll
                for (int bj = 0; bj < 2; ++bj)
#pragma unroll
                    for (int n = 0; n < 2; ++n) v[bj][n] = acc[ai][bj][m][n] * r;
                if (mode == 1 || mode == 2) {
                    float ss = 0.f;
#pragma unroll
                    for (int bj = 0; bj < 2; ++bj)
#pragma unroll
                        for (int n = 0; n < 2; ++n) { const f32x4 x = v[bj][n]; ss += (x[0] * x[0] + x[1] * x[1]) + (x[2] * x[2] + x[3] * x[3]); }
                    ss += __shfl_xor(ss, 16); ss += __shfl_xor(ss, 32);
                    const float rn = qs * __builtin_amdgcn_rsqf(ss * (1.0f / 64.0f) + 1e-6f);
#pragma unroll
                    for (int bj = 0; bj < 2; ++bj)
#pragma unroll
                        for (int n = 0; n < 2; ++n) v[bj][n] = v[bj][n] * rn * gv[bj][n];
                } else if (mode == 3) {
#pragma unroll
                    for (int bj = 0; bj < 2; ++bj)
#pragma unroll
                        for (int n = 0; n < 2; ++n)
#pragma unroll
                            for (int e = 0; e < 4; ++e) { const float x = v[bj][n][e]; v[bj][n][e] = x * __builtin_amdgcn_rcpf(1.0f + __builtin_amdgcn_exp2f(x * -1.4426950408889634f)); }
                }
                bf16_t* rowp = O + (size_t)row * ldc + lt * BM + wc * 64 + 8 * fq;
#pragma unroll
                for (int bj = 0; bj < 2; ++bj) { u32x4 w; w.x = cvt_pk_bf16(v[bj][0][0], v[bj][0][1]); w.y = cvt_pk_bf16(v[bj][0][2], v[bj][0][3]); w.z = cvt_pk_bf16(v[bj][1][0], v[bj][1][1]); w.w = cvt_pk_bf16(v[bj][1][2], v[bj][1][3]);
                    *(u32x4*)(rowp + bj * 32) = w; }
            }
        }
    }
};
struct EpiOut {
    static constexpr bool PERM = true, AFTER_DRAIN = false;
    const float* base; const bf16_t* base16; float* out; bf16_t* xb; float* ssq;
    __device__ __forceinline__ void operator()(const f32x4 (&acc)[2][2][4][2], const Unit& u, int wr, int wc, int fr, int fq) const {
        const int col0 = u.pn * BM + wc * 32 + 8 * fq;
#pragma unroll
        for (int ai = 0; ai < 2; ++ai) {
            f32x4 pre[4][2][2];
#pragma unroll
            for (int m = 0; m < 4; ++m) { const size_t off = (size_t)(u.pm * BM + ai * HALF + wr * 64 + m * 16 + fr) * 1024 + col0;
#pragma unroll
                for (int bj = 0; bj < 2; ++bj) {
                    if (base16) { const u32x4 w = *(const u32x4*)(base16 + off + bj * HALF);
                        pre[m][bj][0] = (f32x4){__uint_as_float(w.x << 16), __uint_as_float(w.x & 0xffff0000u), __uint_as_float(w.y << 16), __uint_as_float(w.y & 0xffff0000u)};
                        pre[m][bj][1] = (f32x4){__uint_as_float(w.z << 16), __uint_as_float(w.z & 0xffff0000u), __uint_as_float(w.w << 16), __uint_as_float(w.w & 0xffff0000u)}; }
                    else { pre[m][bj][0] = *(const f32x4*)(base + off + bj * HALF); pre[m][bj][1] = *(const f32x4*)(base + off + bj * HALF + 4); } } }
            asm volatile("" ::: "memory");
#pragma unroll
            for (int m = 0; m < 4; ++m) {
                const int row = u.pm * BM + ai * HALF + wr * 64 + m * 16 + fr;
                const size_t off = (size_t)row * 1024 + col0;
                float ss = 0.f;
#pragma unroll
                for (int bj = 0; bj < 2; ++bj) {
                    const f32x4 o0 = pre[m][bj][0] + acc[ai][bj][m][0], o1 = pre[m][bj][1] + acc[ai][bj][m][1];
                    if (out) { *(f32x4*)(out + off + bj * HALF) = o0; *(f32x4*)(out + off + bj * HALF + 4) = o1; }
                    ss += (o0[0] * o0[0] + o0[1] * o0[1]) + (o0[2] * o0[2] + o0[3] * o0[3]) + (o1[0] * o1[0] + o1[1] * o1[1]) + (o1[2] * o1[2] + o1[3] * o1[3]);
                    if (xb) { u32x4 w; w.x = cvt_pk_bf16(o0[0], o0[1]); w.y = cvt_pk_bf16(o0[2], o0[3]); w.z = cvt_pk_bf16(o1[0], o1[1]); w.w = cvt_pk_bf16(o1[2], o1[3]);
                        *(u32x4*)(xb + off + bj * HALF) = w; }
                }
                if (ssq) { ss += __shfl_xor(ss, 16); ss += __shfl_xor(ss, 32); if (fq == 0) ssq[(size_t)row * 16 + u.pn * 4 + wc] = ss; }
            }
            asm volatile("" ::: "memory");
        }
    }
};

template <class Epi, class Sched, bool ALIGN_EPI = false, bool SP2 = false>
__device__ __forceinline__ void gemm_phase(PG8_LAS unsigned char* lds, const Gemm g, const Sched& S, const Epi& E) {
    const int tid = threadIdx.x, wid = __builtin_amdgcn_readfirstlane(tid >> 6), lane = tid & 63, wr = wid >> 2, wc = wid & 3, fr = lane & 15, fq = lane >> 4;
    const int K = g.K, nt = K / BK;
    unsigned voffA[2], voffB[2];
#pragma unroll
    for (int i = 0; i < 2; ++i) { int R, C; stage_rc(tid * 16 + i * 8192, R, C); const int Rb = Epi::PERM ? ((R & ~31) + perm32(R & 31)) : R;
        voffA[i] = (unsigned)(R * K + C) * 2u; voffB[i] = (unsigned)(Rb * K + C) * 2u; }
    const size_t kstep = (size_t)(BK * 2);
    const size_t hstep = (size_t)HALF * K * 2;
    const size_t tstep = 2 * hstep;
    const unsigned ldsw = (unsigned)wid * 1024u;
    const int aoff = lds_byte(wr * 64 + fr, fq * 8), boff = lds_byte(wc * 32 + fr, fq * 8);
#define PG8_SA(b, h) (((b) * 2 + (h)) * HTB)
#define PG8_SB(b, h) ((4 + (b) * 2 + (h)) * HTB)
#define PG8_STAGE(bufoff, gbase, voff) do { _Pragma("unroll") for (int _i = 0; _i < 2; ++_i) \
        __builtin_amdgcn_global_load_lds((const unsigned*)((const char*)(gbase) + (voff)[_i]), (PG8_LAS unsigned*)(lds + (bufoff) + ldsw + _i * 8192), 16, 0, 0); } while (0)
#define PG8_LDA(dst, b, h) do { _Pragma("unroll") for (int m = 0; m < 4; ++m) _Pragma("unroll") for (int k = 0; k < 2; ++k) dst[m][k] = *(const PG8_LAS bf16x8*)(lds + PG8_SA(b, h) + aoff + m * 2048 + k * 1024); } while (0)
#define PG8_LDB(dst, b, h) do { _Pragma("unroll") for (int n = 0; n < 2; ++n) _Pragma("unroll") for (int k = 0; k < 2; ++k) dst[n][k] = *(const PG8_LAS bf16x8*)(lds + PG8_SB(b, h) + boff + n * 2048 + k * 1024); } while (0)
#define PG8_MMA(ai, bj, At, Bt) do { __builtin_amdgcn_s_setprio(1); _Pragma("unroll") for (int m = 0; m < 4; ++m) _Pragma("unroll") for (int n = 0; n < 2; ++n) _Pragma("unroll") for (int k = 0; k < 2; ++k) \
        acc[ai][bj][m][n] = __builtin_amdgcn_mfma_f32_16x16x32_bf16(Bt[n][k], At[m][k], acc[ai][bj][m][n], 0, 0, 0); __builtin_amdgcn_s_setprio(0); } while (0)
#define PG8_WAIT_V(n) asm volatile("s_waitcnt vmcnt(" #n ")" ::: "memory")
#define PG8_WAIT_L(n) asm volatile("s_waitcnt lgkmcnt(" #n ")" ::: "memory")
#define PG8_BAR __builtin_amdgcn_s_barrier()
#define PG8_SCHED __builtin_amdgcn_sched_barrier(0)
    Unit cur, nxt; int ui = 0;
    if (!S.next(0, cur)) return;
    f32x4 acc[2][2][4][2];
#pragma unroll
    for (int a = 0; a < 2; ++a)
#pragma unroll
        for (int b = 0; b < 2; ++b)
#pragma unroll
            for (int m = 0; m < 4; ++m)
#pragma unroll
                for (int n = 0; n < 2; ++n) acc[a][b][m][n] = (f32x4){0.f, 0.f, 0.f, 0.f};
    bf16x8 At[4][2], B0[2][2], B1[2][2];
    const char* cA = (const char*)g.A + (size_t)cur.pm * tstep; const char* cB = (const char*)g.Bt + (size_t)cur.pn * tstep;
    S.a_ready(cur);
    if constexpr (SP2) {
        PG8_STAGE(PG8_SB(0, 0), cB, voffB); PG8_STAGE(PG8_SB(0, 1), cB + hstep, voffB); PG8_STAGE(PG8_SA(0, 0), cA, voffA); PG8_STAGE(PG8_SA(0, 1), cA + hstep, voffA);
        if (wr == 1) PG8_BAR;
        PG8_WAIT_V(2); PG8_BAR;
        PG8_STAGE(PG8_SB(1, 0), cB + kstep, voffB); PG8_STAGE(PG8_SA(1, 0), cA + kstep, voffA); PG8_STAGE(PG8_SB(1, 1), cB + hstep + kstep, voffB);
        PG8_WAIT_V(6); PG8_BAR;
    } else {
        PG8_STAGE(PG8_SB(0, 0), cB, voffB); PG8_STAGE(PG8_SA(0, 0), cA, voffA); PG8_STAGE(PG8_SB(0, 1), cB + hstep, voffB); PG8_STAGE(PG8_SA(0, 1), cA + hstep, voffA);
        if (wr == 1) PG8_BAR;
        PG8_WAIT_V(4); PG8_BAR;
        PG8_STAGE(PG8_SB(1, 0), cB + kstep, voffB); PG8_STAGE(PG8_SA(1, 0), cA + kstep, voffA); PG8_STAGE(PG8_SB(1, 1), cB + hstep + kstep, voffB);
        PG8_WAIT_V(6); PG8_BAR;
    }
    for (;;) {
        const bool has_next = S.next(ui + 1, nxt);
        const char* nA = has_next ? (const char*)g.A + (size_t)nxt.pm * tstep : cA; const char* nB = has_next ? (const char*)g.Bt + (size_t)nxt.pn * tstep : cB;
        for (int t = 0; t < nt; t += 2) {
            const bool last = (t == nt - 2);
            const char* a1 = cA + (size_t)(t + 1) * kstep;
            const char* a2 = last ? nA : cA + (size_t)(t + 2) * kstep; const char* b2 = last ? nB : cB + (size_t)(t + 2) * kstep;
            const char* a3 = a2 + kstep; const char* b3 = b2 + kstep;
            if (last && has_next) S.a_ready(nxt);
            if constexpr (SP2) {
            PG8_LDB(B0, 0, 0); PG8_LDB(B1, 0, 1); PG8_SCHED; PG8_LDA(At, 0, 0); PG8_STAGE(PG8_SA(1, 1), a1 + hstep, voffA);
            PG8_WAIT_V(8); PG8_WAIT_L(0); PG8_BAR; PG8_MMA(0, 0, At, B0); PG8_MMA(0, 1, At, B1); PG8_BAR; PG8_SCHED;
            PG8_LDA(At, 0, 1); PG8_STAGE(PG8_SB(0, 0), b2, voffB); PG8_STAGE(PG8_SB(0, 1), b2 + hstep, voffB); PG8_STAGE(PG8_SA(0, 0), a2, voffA);
            PG8_WAIT_V(8); PG8_WAIT_L(0); PG8_BAR; PG8_MMA(1, 0, At, B0); PG8_MMA(1, 1, At, B1); PG8_BAR; PG8_SCHED;
            PG8_LDB(B0, 1, 0); PG8_LDB(B1, 1, 1); PG8_SCHED; PG8_LDA(At, 1, 0); PG8_STAGE(PG8_SA(0, 1), a2 + hstep, voffA);
            PG8_WAIT_V(8); PG8_WAIT_L(0); PG8_BAR; PG8_MMA(0, 0, At, B0); PG8_MMA(0, 1, At, B1); PG8_BAR; PG8_SCHED;
            PG8_LDA(At, 1, 1); PG8_STAGE(PG8_SB(1, 0), b3, voffB); PG8_STAGE(PG8_SB(1, 1), b3 + hstep, voffB); PG8_STAGE(PG8_SA(1, 0), a3, voffA);
            PG8_WAIT_V(8); PG8_WAIT_L(0); PG8_BAR; PG8_MMA(1, 0, At, B0); PG8_MMA(1, 1, At, B1); PG8_BAR; PG8_SCHED;
            } else {
            PG8_LDB(B0, 0, 0); PG8_SCHED; PG8_LDA(At, 0, 0); PG8_STAGE(PG8_SA(1, 1), a1 + hstep, voffA);
            PG8_WAIT_L(8); PG8_BAR; PG8_WAIT_L(0); PG8_MMA(0, 0, At, B0); PG8_BAR; PG8_SCHED;
            PG8_LDB(B1, 0, 1); PG8_STAGE(PG8_SB(0, 0), b2, voffB);
            PG8_BAR; PG8_WAIT_L(0); PG8_MMA(0, 1, At, B1); PG8_BAR;
            PG8_LDA(At, 0, 1); PG8_STAGE(PG8_SA(0, 0), a2, voffA);
            PG8_BAR; PG8_WAIT_L(0); PG8_MMA(1, 0, At, B0); PG8_BAR; PG8_SCHED;
            PG8_STAGE(PG8_SB(0, 1), b2 + hstep, voffB);
            PG8_WAIT_V(6); PG8_BAR; PG8_MMA(1, 1, At, B1); PG8_BAR;
            PG8_LDB(B0, 1, 0); PG8_SCHED; PG8_LDA(At, 1, 0); PG8_STAGE(PG8_SA(0, 1), a2 + hstep, voffA);
            PG8_WAIT_L(8); PG8_BAR; PG8_WAIT_L(0); PG8_MMA(0, 0, At, B0); PG8_BAR; PG8_SCHED;
            PG8_LDB(B1, 1, 1); PG8_STAGE(PG8_SB(1, 0), b3, voffB);
            PG8_BAR; PG8_WAIT_L(0); PG8_MMA(0, 1, At, B1); PG8_BAR;
            PG8_LDA(At, 1, 1); PG8_STAGE(PG8_SA(1, 0), a3, voffA);
            PG8_BAR; PG8_WAIT_L(0); PG8_MMA(1, 0, At, B0); PG8_BAR; PG8_SCHED;
            PG8_STAGE(PG8_SB(1, 1), b3 + hstep, voffB);
            PG8_WAIT_V(6); PG8_BAR; PG8_MMA(1, 1, At, B1); PG8_BAR;
            }
        }
        if constexpr (ALIGN_EPI) { if (wr == 0) PG8_BAR; }
        if constexpr (!Epi::AFTER_DRAIN) { E(acc, cur, wr, wc, fr, fq); S.done(cur); }
        if (!has_next) break;
#pragma unroll
        for (int a = 0; a < 2; ++a)
#pragma unroll
            for (int b = 0; b < 2; ++b)
#pragma unroll
                for (int m = 0; m < 4; ++m)
#pragma unroll
                    for (int n = 0; n < 2; ++n) acc[a][b][m][n] = (f32x4){0.f, 0.f, 0.f, 0.f};
        cur = nxt; cA = nA; cB = nB; ++ui;
        if constexpr (ALIGN_EPI) { if (wr == 1) PG8_BAR; }
    }
    PG8_WAIT_V(0);
    if constexpr (!ALIGN_EPI) { if (wr == 0) PG8_BAR; }
    PG8_BAR;
    if constexpr (Epi::AFTER_DRAIN) { E.fused(acc, cur, wr, wc, fr, fq, lds, wid, lane); S.done(cur); }
#undef PG8_SA
#undef PG8_SB
#undef PG8_STAGE
#undef PG8_LDA
#undef PG8_LDB
#undef PG8_MMA
#undef PG8_WAIT_V
#undef PG8_WAIT_L
#undef PG8_BAR
#undef PG8_SCHED
}
}
#define PG8_SP2 true
#define PG8_ALIGN true
namespace att {
typedef unsigned short bf16_t;
typedef __attribute__((address_space(3))) unsigned char* lptr;
typedef __attribute__((address_space(3))) const unsigned char* lcptr;
typedef short bf16x8 __attribute__((ext_vector_type(8)));
typedef short s16x4 __attribute__((ext_vector_type(4)));
typedef float f32x16 __attribute__((ext_vector_type(16)));
typedef float f32x4 __attribute__((ext_vector_type(4)));
typedef unsigned u32x4 __attribute__((ext_vector_type(4)));
typedef unsigned u32x2 __attribute__((ext_vector_type(2)));
typedef float f32x2_t __attribute__((ext_vector_type(2)));
typedef __bf16 bf16x2_t __attribute__((ext_vector_type(2)));
constexpr float LOG2E = 1.4426950408889634f;
constexpr int SLOT = 32768, LDS_CUM = 65536, LDS_TAB = 81920;
__device__ __forceinline__ unsigned cvtpk(float lo, float hi) { f32x2_t v = {lo, hi}; bf16x2_t b = __builtin_convertvector(v, bf16x2_t); return __builtin_bit_cast(unsigned, b); }
__device__ __forceinline__ float bf2f(unsigned short h) { return __uint_as_float(((unsigned)h) << 16); }
__device__ __forceinline__ void glds16(const void* gsrc, unsigned lds_dst) { unsigned keep;
    asm volatile("s_mov_b32 %0, m0\n\ts_mov_b32 m0, %2\n\ts_nop 0\n\tglobal_load_lds_dwordx4 %1, off\n\ts_mov_b32 m0, %0" : "=&s"(keep) : "v"(gsrc), "s"(lds_dst) : "memory"); }
__device__ __forceinline__ float fadd_s(float a, float b) { return a + b; }
__device__ __forceinline__ float fsub_s(float a, float b) { return a - b; }
__device__ __forceinline__ s16x4 vtr(lcptr p) { return __builtin_bit_cast(s16x4, __builtin_amdgcn_ds_read_tr16_b64_v4i16((__attribute__((address_space(3))) s16x4*)p)); }

template <int VD, int NK, int MODE>
__device__ __forceinline__ void attn_core(lptr lds, const bf16_t* Zb, int ldz, int qcol, int kcol0, int kcol1, int vcol, int q0w,
                                          int t_lo, int t_hi, int w_lo, int w_hi, int ksel, float nsl, int diag_t,
                                          f32x16 (&o)[2 * VD], float mref, float& l_run, int gcol, u32x4 (&gpre)[4]) {
    const int tid = threadIdx.x, lane = tid & 63, r32 = lane & 31, hi = lane >> 5;
    const int wv_ = __builtin_amdgcn_readfirstlane(tid >> 6);
    const int krow_ = 8 * wv_ + (lane >> 3), kchk_ = (lane & 7) ^ ((krow_ >> 1) & 7);
    const bf16_t* ksrc0 = Zb + (size_t)krow_ * ldz + kcol0 + kchk_ * 8;
    const bf16_t* ksrc1 = Zb + (size_t)krow_ * ldz + kcol1 + kchk_ * 8;
    const bf16_t* vsrc = Zb + (size_t)krow_ * ldz + vcol + ((lane & 7) ^ (4 * ((lane >> 4) & 1))) * 8;
    const unsigned lds0 = (unsigned)(uintptr_t)lds + (unsigned)wv_ * 1024u;
#define ATT_DMA(t, sl) do { const size_t go_ = (size_t)(t) * 64 * ldz; const unsigned d_ = (unsigned)__builtin_amdgcn_readfirstlane(lds0 + (unsigned)(sl) * SLOT); \
        glds16(ksrc0 + go_, d_); if (NK == 2) glds16(ksrc1 + go_, d_ + 8192u); glds16(vsrc + go_, d_ + 16384u); if (VD == 2) glds16(vsrc + go_ + 64, d_ + 24576u); } while (0)
#define ATT_DMA_WAIT() asm volatile("s_waitcnt vmcnt(0)" ::: "memory")
    bf16x8 qr[4];
    { const bf16_t* qp = Zb + (size_t)(q0w + r32) * ldz + qcol + hi * 8;
#pragma unroll
      for (int d0 = 0; d0 < 4; ++d0) qr[d0] = *(const bf16x8*)(qp + d0 * 16); }
#pragma unroll
    for (int i = 0; i < 2 * VD; ++i) o[i] = f32x16{};
    const float m = mref; float l = 0.f;
    const int qabs = q0w + r32;
    unsigned koff[4];
#pragma unroll
    for (int d0 = 0; d0 < 4; ++d0) koff[d0] = (unsigned)(ksel * 8192 + r32 * 128 + (((2 * d0 + hi) ^ ((r32 >> 1) & 7)) << 4));
    unsigned vfr[2];
#pragma unroll
    for (int dh = 0; dh < 2; ++dh) vfr[dh] = (unsigned)(16384 + (4 * hi + ((lane & 15) >> 2)) * 128 + ((dh ^ ((lane >> 3) & 1)) * 64) + ((lane >> 4) & 1) * 32 + (lane & 3) * 8);
    if (gcol >= 0) {
        const bf16_t* gp = Zb + (size_t)(q0w + r32) * ldz + gcol + 8 * hi;
#pragma unroll
        for (int i = 0; i < 4; ++i) gpre[i] = *(const u32x4*)(gp + 32 * (i >> 1) + 16 * (i & 1));
    }
    ATT_DMA(t_lo, 0); ATT_DMA_WAIT();
    if (gcol >= 0) asm volatile("" : "+v"(gpre[0]), "+v"(gpre[1]), "+v"(gpre[2]), "+v"(gpre[3]));
    __syncthreads();
    const float nnsl = -nsl;
    for (int t = t_lo; t <= t_hi; ++t) {
        const int cur = (t - t_lo) & 1;
        const bool act_ = (t >= w_lo && t <= w_hi);
        if (!act_) { if (t < t_hi) ATT_DMA(t + 1, cur ^ 1); }
        if (act_) {
            lcptr sb = (lcptr)(lds + cur * SLOT);
            bf16x8 kf[8];
#pragma unroll
            for (int d0 = 0; d0 < 4; ++d0) { kf[2 * d0] = *(const __attribute__((address_space(3))) bf16x8*)(sb + koff[d0]); kf[2 * d0 + 1] = *(const __attribute__((address_space(3))) bf16x8*)(sb + koff[d0] + 4096); }
            s16x4 vlo[8], vhh[8];
#pragma unroll
            for (int i = 0; i < 8; ++i) { vlo[i] = vtr(sb + vfr[i >> 2] + (i & 3) * 2048); vhh[i] = vtr(sb + vfr[i >> 2] + (i & 3) * 2048 + 1024); }
            __builtin_amdgcn_sched_barrier(0);
            f32x16 p0, p1;
            if (MODE == 0 || MODE == 2) {
                const float fq = (float)(qabs - 64 * t - 4 * hi);
                if (t == w_hi) {
#pragma unroll
                    for (int r = 0; r < 16; ++r) { const float c = (float)((r & 3) + 8 * (r >> 2));
                        p0[r] = __builtin_fmaf(nsl, __builtin_fabsf(fq - c), -m); p1[r] = __builtin_fmaf(nsl, __builtin_fabsf(fq - c - 32.0f), -m); }
                } else {
                    const float sh = __builtin_fmaf(nsl, fq, -m), n8 = 8.0f * nnsl, n32 = 32.0f * nnsl;
                    float bj_ = sh;
#pragma unroll
                    for (int j = 0; j < 4; ++j) { p0[4 * j] = bj_; p0[4 * j + 1] = fadd_s(p0[4 * j], nnsl); p0[4 * j + 2] = fadd_s(p0[4 * j + 1], nnsl); p0[4 * j + 3] = fadd_s(p0[4 * j + 2], nnsl);
                        if (j < 3) bj_ = fadd_s(bj_, n8); }
#pragma unroll
                    for (int r = 0; r < 16; ++r) p1[r] = fadd_s(p0[r], n32);
                }
            } else if (MODE == 1) {
                const __attribute__((address_space(3))) float* cl = (const __attribute__((address_space(3))) float*)(lds + LDS_CUM) + 64 * t + 4 * hi;
#pragma unroll
                for (int j = 0; j < 4; ++j) { const f32x4 c0 = *(const __attribute__((address_space(3))) f32x4*)(cl + 8 * j), c1 = *(const __attribute__((address_space(3))) f32x4*)(cl + 8 * j + 32);
#pragma unroll
                    for (int e = 0; e < 4; ++e) { p0[4 * j + e] = fsub_s(c0[e], m); p1[4 * j + e] = fsub_s(c1[e], m); } }
            } else {
                const __attribute__((address_space(3))) float* tb = (const __attribute__((address_space(3))) float*)(lds + LDS_TAB) + (575 - (qabs - 64 * t - 4 * hi));
#pragma unroll
                for (int r = 0; r < 16; ++r) { const int c = (r & 3) + 8 * (r >> 2); p0[r] = tb[c]; p1[r] = tb[c + 32]; }
            }
#pragma unroll
            for (int d0 = 0; d0 < 4; ++d0) {
                p0 = __builtin_amdgcn_mfma_f32_32x32x16_bf16(kf[2 * d0], qr[d0], p0, 0, 0, 0);
                p1 = __builtin_amdgcn_mfma_f32_32x32x16_bf16(kf[2 * d0 + 1], qr[d0], p1, 0, 0, 0);
            }
            if (t < t_hi) ATT_DMA(t + 1, cur ^ 1);

            if (MODE == 1) { if (t == diag_t) { const int qrel = (qabs & 63) - 4 * hi;
#pragma unroll
                    for (int r = 0; r < 16; ++r) { const int kv = (r & 3) + 8 * (r >> 2); if (kv > qrel) p0[r] = -INFINITY; if (kv + 32 > qrel) p1[r] = -INFINITY; } } }
            float sa = 0.f, sb_ = 0.f;
#pragma unroll
            for (int r = 0; r < 16; ++r) { p0[r] = __builtin_amdgcn_exp2f(p0[r]); p1[r] = __builtin_amdgcn_exp2f(p1[r]); sa = fadd_s(sa, p0[r]); sb_ = fadd_s(sb_, p1[r]); }
            l += sa + sb_;
            u32x4 pw[4];
            pw[0] = (u32x4){cvtpk(p0[0], p0[1]), cvtpk(p0[2], p0[3]), cvtpk(p0[4], p0[5]), cvtpk(p0[6], p0[7])};
            pw[1] = (u32x4){cvtpk(p0[8], p0[9]), cvtpk(p0[10], p0[11]), cvtpk(p0[12], p0[13]), cvtpk(p0[14], p0[15])};
            pw[2] = (u32x4){cvtpk(p1[0], p1[1]), cvtpk(p1[2], p1[3]), cvtpk(p1[4], p1[5]), cvtpk(p1[6], p1[7])};
            pw[3] = (u32x4){cvtpk(p1[8], p1[9]), cvtpk(p1[10], p1[11]), cvtpk(p1[12], p1[13]), cvtpk(p1[14], p1[15])};
#pragma unroll
            for (int i = 0; i < 8; ++i) { const bf16x8 vf = (bf16x8){vlo[i][0], vlo[i][1], vlo[i][2], vlo[i][3], vhh[i][0], vhh[i][1], vhh[i][2], vhh[i][3]};
                o[i >> 2] = __builtin_amdgcn_mfma_f32_32x32x16_bf16(vf, __builtin_bit_cast(bf16x8, pw[i & 3]), o[i >> 2], 0, 0, 0); }
            if (VD == 2) {
#pragma unroll
                for (int i = 0; i < 8; ++i) { const s16x4 lo = vtr(sb + vfr[i >> 2] + 8192 + (i & 3) * 2048), hh = vtr(sb + vfr[i >> 2] + 8192 + (i & 3) * 2048 + 1024);
                    const bf16x8 vf = (bf16x8){lo[0], lo[1], lo[2], lo[3], hh[0], hh[1], hh[2], hh[3]};
                    o[2 + (i >> 2)] = __builtin_amdgcn_mfma_f32_32x32x16_bf16(vf, __builtin_bit_cast(bf16x8, pw[i & 3]), o[2 + (i >> 2)], 0, 0, 0); }
            }
        }
        ATT_DMA_WAIT();
        __syncthreads();
    }
    { auto rr = __builtin_amdgcn_permlane32_swap(__float_as_uint(l), __float_as_uint(l), false, false); l = __uint_as_float(rr[0]) + __uint_as_float(rr[1]); }
    l_run = l;
#undef ATT_DMA
#undef ATT_DMA_WAIT
}
__device__ __forceinline__ void store_gated(const f32x16 (&o)[2], float inv, const u32x4 (&gpre)[4], bf16_t* orow, int hi) {
#pragma unroll
    for (int dh = 0; dh < 2; ++dh)
#pragma unroll
        for (int jp = 0; jp < 2; ++jp) {
            const int cb = 32 * dh + 16 * jp + 8 * hi;
            const u32x4 L = gpre[dh * 2 + jp];
            const auto g0 = __builtin_amdgcn_permlane32_swap(L.x, L.z, false, false), g1 = __builtin_amdgcn_permlane32_swap(L.y, L.w, false, false);
            u32x2 w[2];
#pragma unroll
            for (int q = 0; q < 2; ++q) { const int j = 2 * jp + q; const unsigned gx = q ? g0[1] : g0[0], gy = q ? g1[1] : g1[0];
                const float a0 = __uint_as_float(gx << 16), a1 = __uint_as_float(gx & 0xffff0000u), a2 = __uint_as_float(gy << 16), a3 = __uint_as_float(gy & 0xffff0000u);
                w[q].x = cvtpk(o[dh][4 * j] * inv * a0, o[dh][4 * j + 1] * inv * a1); w[q].y = cvtpk(o[dh][4 * j + 2] * inv * a2, o[dh][4 * j + 3] * inv * a3); }
            const auto s0 = __builtin_amdgcn_permlane32_swap(w[0].x, w[1].x, false, false), s1 = __builtin_amdgcn_permlane32_swap(w[0].y, w[1].y, false, false);
            *(u32x4*)(orow + cb) = (u32x4){s0[0], s1[0], s0[1], s1[1]};
        }
}
}
typedef unsigned short bf16;
typedef float f32x4 __attribute__((ext_vector_type(4)));
typedef float f32x16 __attribute__((ext_vector_type(16)));
typedef unsigned v4u __attribute__((ext_vector_type(4)));
typedef unsigned v2u __attribute__((ext_vector_type(2)));
#define LAS __attribute__((address_space(3)))
constexpr int NWAVES = 8, NTHR = 512;
constexpr int M = 16384, DM = 1024, SEQ = 4096;
constexpr int N0 = 4096, LDW0 = 4104, N1 = 3328;
constexpr size_t MiB = 1u << 20;
constexpr size_t WS_CTL = 0, WS_BT0 = 2 * MiB, WS_BTO0 = 10 * MiB, WS_BT1 = 12 * MiB, WS_BTO1 = 19 * MiB, WS_RS0 = 21 * MiB, WS_LF = 22 * MiB, WS_SSQ = 24 * MiB,
                 WS_XB = 32 * MiB, WS_Z = 64 * MiB, WS_MIX = 192 * MiB, WS_END = 224 * MiB;
constexpr int RING_BYTES = 131072, MISC_OFF = RING_BYTES, LDS_BYTES = RING_BYTES + 4096;
constexpr float LOG2E = 1.4426950408889634f;
constexpr int CW_BAR = 4096;

__device__ __forceinline__ unsigned f2bf(float f) { unsigned u = __builtin_bit_cast(unsigned, f); return (u + 0x7fffu + ((u >> 16) & 1u)) >> 16; }
__device__ __forceinline__ unsigned pk2(float lo, float hi) { return f2bf(lo) | (f2bf(hi) << 16); }
__device__ __forceinline__ float wave_sum(float v) {
#pragma unroll
    for (int o = 1; o < 64; o <<= 1) v += __shfl_xor(v, o);
    return v;
}
__device__ __forceinline__ void p0_transpose_item(const float* W, int ldw, int N, const float* gain, bool permute, int swa, int swb, bf16* WT, LAS float* scr, int item, int lane) {
    const int nblk = N / 32, kb = item / nblk, nb = item % nblk, k0 = 64 * kb, n0 = 32 * nb;
    float wv[32];
#pragma unroll
    for (int i = 0; i < 32; ++i) { const int kk = 2 * i + (lane >> 5); wv[i] = W[(size_t)(k0 + kk) * ldw + n0 + (lane & 31)]; }
    const float gl = gain ? gain[k0 + lane] : 1.0f;
#pragma unroll
    for (int i = 0; i < 32; ++i) { const int kk = 2 * i + (lane >> 5); scr[kk * 33 + (lane & 31)] = wv[i] * __shfl(gl, kk); }
    asm volatile("s_waitcnt lgkmcnt(0)" ::: "memory");
    const int c = lane & 7;
#pragma unroll
    for (int j = 0; j < 4; ++j) { const int n = (lane >> 3) + 8 * j; const LAS float* s = scr + (8 * c) * 33 + n;
        v4u o; o.x = pk2(s[0 * 33], s[1 * 33]); o.y = pk2(s[2 * 33], s[3 * 33]); o.z = pk2(s[4 * 33], s[5 * 33]); o.w = pk2(s[6 * 33], s[7 * 33]);
        int nl = n0 + n;
        if (permute) { int tile = nl >> 8; tile = (tile == swa) ? swb : (tile == swb ? swa : tile);
            const int t = nl & 255; nl = (tile << 8) | (((t >> 5) & 1) << 7) | (((t >> 6) & 3) << 5) | (t & 31); }
        *(v4u*)(WT + (size_t)nl * 1024 + k0 + 8 * c) = o; }
    asm volatile("s_waitcnt lgkmcnt(0)" ::: "memory");
}

struct Params { const float* in[23]; float* out; unsigned char* ws; int ph_lo, ph_hi; };

__device__ __forceinline__ void p0_prologue(const Params& P, LAS unsigned char* lds, int tid, int lane, int wave) {
    const int G = gridDim.x, gw = blockIdx.x * NWAVES + wave, NGW = G * NWAVES;
    unsigned char* ws = P.ws;
    LAS float* wf = (LAS float*)(lds + 98304);
    { float t0[16], t1[16];
#pragma unroll
      for (int u = 0; u < 16; ++u) { const int i = tid + NTHR * u, k = i >> 3, j = i & 7; t0[u] = P.in[1][k]; t1[u] = P.in[2][(size_t)k * LDW0 + N0 + j]; }
#pragma unroll
      for (int u = 0; u < 16; ++u) { const int i = tid + NTHR * u, k = i >> 3, j = i & 7; wf[j * 1024 + k] = t0[u] * t1[u]; } }
    LAS float* scr = (LAS float*)(lds + wave * 8704);
    constexpr int I0 = 16 * (N0 / 32);
    for (int it = gw; it < I0; it += NGW) p0_transpose_item(P.in[2], LDW0, N0, P.in[1], true, -1, -1, (bf16*)(ws + WS_BT0), scr, it, lane);
    __syncthreads();
    const float* x = P.in[0]; bf16* xb = (bf16*)(ws + WS_XB); float* rs0 = (float*)(ws + WS_RS0); float* lf = (float*)(ws + WS_LF);
    f32x4 vn[4];
    if (gw < M) { const f32x4* xr = (const f32x4*)(x + (size_t)gw * DM) + lane;
#pragma unroll
        for (int j = 0; j < 4; ++j) vn[j] = xr[64 * j]; }
    for (int mrow = gw; mrow < M; mrow += NGW) {
        f32x4 v[4];
#pragma unroll
        for (int j = 0; j < 4; ++j) v[j] = vn[j];
        if (mrow + NGW < M) { const f32x4* xr = (const f32x4*)(x + (size_t)(mrow + NGW) * DM) + lane;
#pragma unroll
            for (int j = 0; j < 4; ++j) vn[j] = xr[64 * j]; }
        float s = 0.f; float dj[8];
#pragma unroll
        for (int j = 0; j < 8; ++j) dj[j] = 0.f;
#pragma unroll
        for (int j = 0; j < 4; ++j) { s += (v[j][0] * v[j][0] + v[j][1] * v[j][1]) + (v[j][2] * v[j][2] + v[j][3] * v[j][3]);
#pragma unroll
            for (int jj = 0; jj < 8; ++jj) { const f32x4 w = *(const LAS f32x4*)(wf + jj * 1024 + 4 * (lane + 64 * j));
                dj[jj] += (v[j][0] * w[0] + v[j][1] * w[1]) + (v[j][2] * w[2] + v[j][3] * w[3]); } }
        const float rstd = 1.0f / sqrtf(wave_sum(s) * (1.0f / DM) + 1e-6f);
        float r4[4], r2[2], r1;
#pragma unroll
        for (int i = 0; i < 4; ++i) { const float keep = (lane & 1) ? dj[4 + i] : dj[i], send = (lane & 1) ? dj[i] : dj[4 + i]; r4[i] = keep + __shfl_xor(send, 1); }
#pragma unroll
        for (int i = 0; i < 2; ++i) { const float keep = (lane & 2) ? r4[2 + i] : r4[i], send = (lane & 2) ? r4[i] : r4[2 + i]; r2[i] = keep + __shfl_xor(send, 2); }
        { const float keep = (lane & 4) ? r2[1] : r2[0], send = (lane & 4) ? r2[0] : r2[1]; r1 = keep + __shfl_xor(send, 4); }
        r1 += __shfl_xor(r1, 8); r1 += __shfl_xor(r1, 16); r1 += __shfl_xor(r1, 32);
        const int jo = 4 * (lane & 1) + 2 * ((lane >> 1) & 1) + ((lane >> 2) & 1);
        v2u* o8 = (v2u*)(xb + (size_t)mrow * DM) + lane;
#pragma unroll
        for (int j = 0; j < 4; ++j) { v2u w; w.x = pk2(v[j][0], v[j][1]); w.y = pk2(v[j][2], v[j][3]); o8[64 * j] = w; }
        if (lane == 0) rs0[mrow] = rstd;
        if (lane < 8) { const float z = r1 * rstd + P.in[13][jo]; const float ls = fminf(z, 0.f) - log1pf(expf(-fabsf(z)));
            const int b = mrow >> 12, sidx = mrow & 4095; lf[(size_t)(b * 8 + jo) * SEQ + sidx] = ls; }
    }
    if (wave == 0 && blockIdx.x == 8 % gridDim.x) {
        const float a = wave_sum(P.in[6][lane] * P.in[7][lane]), b = wave_sum(P.in[8][lane] * P.in[9][lane]);
        float ga = fabsf(P.in[4][lane] * P.in[5][lane]), gb = fabsf(P.in[11][lane] * P.in[12][lane]), gc = fabsf(P.in[17][lane] * P.in[18][lane]);
#pragma unroll
        for (int o = 1; o < 64; o <<= 1) { ga = fmaxf(ga, __shfl_xor(ga, o)); gb = fmaxf(gb, __shfl_xor(gb, o)); gc = fmaxf(gc, __shfl_xor(gc, o)); }
        if (lane == 0) { float* ctl = (float*)(ws + WS_CTL); ctl[0] = expf(a) - expf(b) + 0.2f;
            ctl[1] = 8.0f * ga * LOG2E * 1.02f + 0.25f; ctl[2] = 8.0f * gb * LOG2E * 1.02f + 0.25f; ctl[3] = 8.0f * gc * LOG2E * 1.02f + 0.25f; }
    }
    if (wave == 0) {
        for (int hh = blockIdx.x; hh < 8; hh += gridDim.x) {
            float gd = fabsf(P.in[20][lane] * P.in[21][lane]), t = -INFINITY;
            for (int i = lane; i < 320; i += 64) t = fmaxf(t, P.in[22][hh * 320 + i]);
#pragma unroll
            for (int o = 1; o < 64; o <<= 1) { gd = fmaxf(gd, __shfl_xor(gd, o)); t = fmaxf(t, __shfl_xor(t, o)); }
            if (lane == 0) ((float*)(ws + WS_CTL))[8 + hh] = 8.0f * gd * LOG2E * 1.02f + 0.25f + t * LOG2E;
        }
    }
}
constexpr int LATE_W_ITEMS = (16 * (DM / 32) + 16 * (N1 / 32) + 16 * (DM / 32)) / 8;
__device__ __forceinline__ void late_weight_item(const Params& P, LAS unsigned char* lds, int bitem, int lane, int wave) {
    constexpr int IO = 16 * (DM / 32), I1 = 16 * (N1 / 32);
    LAS float* scr = (LAS float*)(lds + wave * 8704);
    int r = bitem * 8 + wave;
    if (r < IO) p0_transpose_item(P.in[3], DM, DM, nullptr, false, -1, -1, (bf16*)(P.ws + WS_BTO0), scr, r, lane);
    else if (r < IO + I1) p0_transpose_item(P.in[15], N1, N1, P.in[14], true, 4, 12, (bf16*)(P.ws + WS_BT1), scr, r - IO, lane);
    else p0_transpose_item(P.in[16], DM, DM, nullptr, false, -1, -1, (bf16*)(P.ws + WS_BTO1), scr, r - IO - I1, lane);
    __syncthreads();
}
#define XB_TMO      128
#define XB_XCNT(j)  (256  + 64 * (j))
#define XB_XSUB(j)  (1280 + 64 * (j))
#define XB_XGEN(j)  (2304 + 64 * (j))
#define XB_TOP      3328
#define XB_TOPGEN   3392
#define XCD_BAR_WORDS 3456
#define XB_SPIN_CAP (1u << 18)

__device__ __forceinline__ unsigned xb_ld(unsigned* p)              { return __hip_atomic_load(p, __ATOMIC_RELAXED, __HIP_MEMORY_SCOPE_AGENT); }
__device__ __forceinline__ unsigned xb_add(unsigned* p, unsigned v) { return __hip_atomic_fetch_add(p, v, __ATOMIC_RELAXED, __HIP_MEMORY_SCOPE_AGENT); }
__device__ __forceinline__ unsigned xb_xcc_id() { return (unsigned)__builtin_amdgcn_s_getreg((3 << 11) | 20) & 0xFu; }
#define XB_SPIN(cond, bar) do { unsigned _sp = 0; while (cond) { __builtin_amdgcn_s_sleep(1); \
    if ((++_sp & 255u) == 0u) { if (xb_ld(&(bar)[XB_TMO])) break; if (_sp > XB_SPIN_CAP) { atomicAdd(&(bar)[XB_TMO], 1u); break; } } } } while (0)

struct XcdBarrier {
    unsigned* bar; unsigned x;
    volatile LAS unsigned* st;
};

__device__ __forceinline__ XcdBarrier xcd_barrier_post(unsigned* bar, volatile LAS unsigned* st) {
    XcdBarrier b; b.bar = bar; b.x = xb_xcc_id(); b.st = st;
    if (threadIdx.x == 0) (void)xb_add(&bar[XB_XCNT(b.x)], 1u);
    return b;
}
__device__ __forceinline__ void xcd_barrier_complete(unsigned* bar, unsigned x, unsigned& nloc, unsigned& nx) {
    const unsigned G = gridDim.x * gridDim.y * gridDim.z;
    unsigned sum, cnt, mine, sp = 0u;
    for (;;) {
        sum = 0u; cnt = 0u; mine = 0u;
#pragma unroll
        for (unsigned j = 0; j < 16; ++j) { const unsigned c = xb_ld(&bar[XB_XCNT(j)]); sum += c; cnt += (c > 0u) ? 1u : 0u; mine = (j == x) ? c : mine; }
        if (sum == G) break;
        __builtin_amdgcn_s_sleep(1);
        if ((++sp & 255u) == 0u) { if (xb_ld(&bar[XB_TMO])) break; if (sp > XB_SPIN_CAP) { atomicAdd(&bar[XB_TMO], 1u); break; } }
    }
    nloc = mine > 0u ? mine : 1u; nx = cnt > 0u ? cnt : 1u;
}

__device__ __forceinline__ void xcd_barrier(const XcdBarrier& b) {
    asm volatile("s_waitcnt vmcnt(0)" ::: "memory");
    __syncthreads();
    if (threadIdx.x == 0) {
        unsigned* bar = b.bar;
        __builtin_amdgcn_s_waitcnt(0);
        unsigned nloc = b.st[0], nx = b.st[1];
        if (nloc == 0u) { xcd_barrier_complete(bar, b.x, nloc, nx); b.st[0] = nloc; b.st[1] = nx; }
        const unsigned old = xb_add(&bar[XB_XSUB(b.x)], 1u);
        const unsigned gen = old / nloc;
        if (old + 1u == (gen + 1u) * nloc) {
            __builtin_amdgcn_fence(__ATOMIC_RELEASE, "agent");
            asm volatile("s_waitcnt vmcnt(0)" ::: "memory");
            const unsigned og = xb_add(&bar[XB_TOP], 1u);
            const unsigned tg = og / nx;
            if (og + 1u == (tg + 1u) * nx) xb_add(&bar[XB_TOPGEN], 1u);
            else XB_SPIN(xb_ld(&bar[XB_TOPGEN]) == tg, bar);
            __builtin_amdgcn_fence(__ATOMIC_ACQUIRE, "agent");
            xb_add(&bar[XB_XGEN(b.x)], 1u);
            asm volatile("s_waitcnt vmcnt(0)" ::: "memory");
        } else {
            XB_SPIN(xb_ld(&bar[XB_XGEN(b.x)]) == gen, bar);
            __builtin_amdgcn_fence(__ATOMIC_ACQUIRE, "agent");
            asm volatile("s_waitcnt vmcnt(0)" ::: "memory");
        }
    }
    __syncthreads();
}

__device__ __forceinline__ void unit_A(const Params& P, LAS unsigned char* lds, int bh, int qa, int tid, int lane, int wave) {
    const int b = bh >> 2, h = bh & 3, r32 = lane & 31, hi = lane >> 5;
    const bf16* Zb = (const bf16*)(P.ws + WS_Z) + (size_t)b * SEQ * N0;
    const int c = wave >> 2, j = wave & 3, q0w = 128 * qa + 32 * j, chunk = 2 * qa + (j >> 1);
    const float slope = exp2f(-2.0f * (float)(h + 1));
    const float thr = 150.0f / (slope * LOG2E);
    const int t_lo = max(0, (int)ceilf(((float)(128 * qa) - thr - 63.0f) * (1.0f / 64.0f))), w_lo = max(0, (int)ceilf(((float)q0w - thr - 63.0f) * (1.0f / 64.0f)));
    f32x16 o[4]; float l; att::u32x4 gdum[4];
    att::attn_core<2, 2, 0>(lds, Zb, N0, h * 128 + c * 64, 512 + h * 128, 512 + h * 128 + 64, 1024 + h * 128, q0w, t_lo, 2 * qa + 1, w_lo, chunk, c, -slope * LOG2E, -1, o, ((const float*)(P.ws + WS_CTL))[1], l, -1, gdum);
    const float inv = 1.0f / l;
    LAS f32x4* xs = (LAS f32x4*)lds + j * 1024 + lane;
    if (c == 1) {
#pragma unroll
        for (int i = 0; i < 4; ++i)
#pragma unroll
            for (int r4 = 0; r4 < 4; ++r4) xs[(i * 4 + r4) * 64] = (f32x4){o[i][4 * r4] * inv, o[i][4 * r4 + 1] * inv, o[i][4 * r4 + 2] * inv, o[i][4 * r4 + 3] * inv};
    }
    __syncthreads();
    if (c == 0) {
        const float lam = ((const float*)(P.ws + WS_CTL))[0];
        float ss = 0.f;
#pragma unroll
        for (int i = 0; i < 4; ++i)
#pragma unroll
            for (int r4 = 0; r4 < 4; ++r4) { const f32x4 x1 = xs[(i * 4 + r4) * 64];
#pragma unroll
                for (int e = 0; e < 4; ++e) { const float v = o[i][4 * r4 + e] * inv - lam * x1[e]; o[i][4 * r4 + e] = v; ss += v * v; } }
        ss += __shfl_xor(ss, 32);
        const float rn = 0.8f / sqrtf(ss * (1.0f / 128.0f) + 1e-6f);
        const size_t row = (size_t)b * SEQ + q0w + r32;
        const bf16* grow = (const bf16*)(P.ws + WS_Z) + row * N0 + 1536 + h * 128;
        bf16* orow = (bf16*)(P.ws + WS_MIX) + row * DM + h * 128;
        const float* sg = P.in[10];
#pragma unroll
        for (int i = 0; i < 4; ++i)
#pragma unroll
            for (int jp = 0; jp < 2; ++jp) {
                const int cb = 32 * i + 16 * jp + 8 * hi;
                const v4u L = *(const v4u*)(grow + cb);
                const auto g0 = __builtin_amdgcn_permlane32_swap(L.x, L.z, false, false), g1 = __builtin_amdgcn_permlane32_swap(L.y, L.w, false, false);
                v2u w[2];
#pragma unroll
                for (int q = 0; q < 2; ++q) { const int jj = 2 * jp + q, d = 32 * i + 8 * jj + 4 * hi; const unsigned gx = q ? g0[1] : g0[0], gy = q ? g1[1] : g1[0];
                    const f32x4 s4 = *(const f32x4*)(sg + d);
                    const float a0 = __uint_as_float(gx << 16), a1 = __uint_as_float(gx & 0xffff0000u), a2 = __uint_as_float(gy << 16), a3 = __uint_as_float(gy & 0xffff0000u);
                    w[q].x = att::cvtpk(o[i][4 * jj] * rn * s4[0] * a0, o[i][4 * jj + 1] * rn * s4[1] * a1); w[q].y = att::cvtpk(o[i][4 * jj + 2] * rn * s4[2] * a2, o[i][4 * jj + 3] * rn * s4[3] * a3); }
                const auto s0 = __builtin_amdgcn_permlane32_swap(w[0].x, w[1].x, false, false), s1 = __builtin_amdgcn_permlane32_swap(w[0].y, w[1].y, false, false);
                *(v4u*)(orow + cb) = (v4u){s0[0], s1[0], s0[1], s1[1]};
            }
    }
    __syncthreads();
}
__device__ __forceinline__ void unit_B(const Params& P, LAS unsigned char* lds, int bh, int qb, int tid, int lane, int wave) {
    const int b = bh >> 3, h = bh & 7, r32 = lane & 31, hi = lane >> 5;
    const bf16* Zb = (const bf16*)(P.ws + WS_Z) + (size_t)b * SEQ * N0;
    const int q0w = 256 * qb + 32 * wave, chunk = 4 * qb + (wave >> 1);
    {
        const float* lfs = (const float*)(P.ws + WS_LF) + (size_t)bh * SEQ;
        LAS float* cl = (LAS float*)(lds + att::LDS_CUM);
        LAS float* part = (LAS float*)(lds + MISC_OFF + 256);
        const int n = 256 * (qb + 1); const bool mine = tid * 8 < n;
        f32x4 a4 = (f32x4){0.f, 0.f, 0.f, 0.f}, b4 = a4;
        if (mine) { const f32x4* src = (const f32x4*)(lfs + tid * 8); a4 = src[0]; b4 = src[1]; }
        float v0 = a4[0], v1 = v0 + a4[1], v2 = v1 + a4[2], v3 = v2 + a4[3], v4 = v3 + b4[0], v5 = v4 + b4[1], v6 = v5 + b4[2], v7 = v6 + b4[3];
        float inc = v7;
#pragma unroll
        for (int o_ = 1; o_ < 64; o_ <<= 1) { const float t_ = __shfl_up(inc, o_); if (lane >= o_) inc += t_; }
        if (lane == 63) part[wave] = inc;
        __syncthreads();
        float base = inc - v7;
#pragma unroll
        for (int w_ = 0; w_ < 8; ++w_) if (w_ < wave) base += part[w_];
        if (tid == 32 * qb) part[8] = v0 + base;
        __syncthreads();
        const float cref = part[8];
        if (mine) { LAS f32x4* dst = (LAS f32x4*)(cl + tid * 8);
            dst[0] = (f32x4){(cref - (v0 + base)) * LOG2E, (cref - (v1 + base)) * LOG2E, (cref - (v2 + base)) * LOG2E, (cref - (v3 + base)) * LOG2E};
            dst[1] = (f32x4){(cref - (v4 + base)) * LOG2E, (cref - (v5 + base)) * LOG2E, (cref - (v6 + base)) * LOG2E, (cref - (v7 + base)) * LOG2E}; }
    }
    __syncthreads();
    const float mrow = ((const float*)(P.ws + WS_CTL))[2] + ((const LAS float*)(lds + att::LDS_CUM))[q0w + r32];
    int t_lo, w_lo;
    { const LAS float* cl = (const LAS float*)(lds + att::LDS_CUM); const int ti = lane <= 4 * qb + 3 ? lane : 4 * qb + 3; const float ce = cl[64 * ti + 63];
      const unsigned long long kw = __ballot(ce - cl[q0w] >= -150.0f), kb = __ballot(ce - cl[256 * qb] >= -150.0f);
      w_lo = kw ? (int)__builtin_ctzll(kw) : chunk; t_lo = kb ? (int)__builtin_ctzll(kb) : 4 * qb; if (w_lo > chunk) w_lo = chunk; }
    t_lo = __builtin_amdgcn_readfirstlane(t_lo); w_lo = __builtin_amdgcn_readfirstlane(w_lo);
    f32x16 o[2]; float l; att::u32x4 gpre[4];
    att::attn_core<1, 1, 1>(lds, Zb, N0, 2048 + h * 64, 2560 + h * 64, 0, 3072 + h * 64, q0w, t_lo, 4 * qb + 3, w_lo, chunk, 0, 0.f, chunk, o, mrow, l, 3584 + h * 64, gpre);
    const size_t row = (size_t)b * SEQ + q0w + r32;
    att::store_gated(o, 1.0f / l, gpre, (bf16*)(P.ws + WS_MIX) + row * DM + 512 + h * 64, hi);
}
__device__ __forceinline__ void unit_C(const Params& P, LAS unsigned char* lds, int b, int kvh, int c, int tid, int lane, int wave) {
    const int r32 = lane & 31, hi = lane >> 5, h = kvh * 4 + (wave >> 1);
    const bf16* Zb = (const bf16*)(P.ws + WS_Z) + (size_t)b * SEQ * N1;
    const int q0w = 64 * c + 32 * (wave & 1);
    const int t_lo = (c - 2) > 0 ? c - 2 : 0;
    const float slope = exp2f(-(float)(h + 1));
    const float m = ((const float*)(P.ws + WS_CTL))[3];
    f32x16 o[2]; float l; att::u32x4 gpre[4];
    att::attn_core<1, 1, 2>(lds, Zb, N1, h * 64, 512 + kvh * 64, 0, 640 + kvh * 64, q0w, t_lo, c, t_lo, c, 0, -slope * LOG2E, -1, o, m, l, 768 + h * 64, gpre);
    l += exp2f(P.in[19][h] * LOG2E - m);
    const size_t row = (size_t)b * SEQ + q0w + r32;
    att::store_gated(o, 1.0f / l, gpre, (bf16*)(P.ws + WS_MIX) + row * DM + h * 64, hi);
}
__device__ __forceinline__ void unit_D(const Params& P, LAS unsigned char* lds, int bh, int qb, int tid, int lane, int wave) {
    const int b = bh >> 3, h = bh & 7, r32 = lane & 31, hi = lane >> 5;
    const bf16* Zb = (const bf16*)(P.ws + WS_Z) + (size_t)b * SEQ * N1;
    const int q0w = 256 * qb + 32 * wave, chunk = 4 * qb + (wave >> 1);
    const int t_lo = (4 * qb - 8) > 0 ? 4 * qb - 8 : 0, w_lo = (chunk - 8) > 0 ? chunk - 8 : 0;
    { LAS float* tb = (LAS float*)(lds + att::LDS_TAB); const float* rt = P.in[22] + h * 320;
      const float mh = ((const float*)(P.ws + WS_CTL))[8 + h];
      for (int i = tid; i < 640; i += NTHR) { const int e = 638 - i; tb[i] = rt[e < 319 ? (e < 0 ? 0 : e) : 319] * LOG2E - mh; } }
    const float m = ((const float*)(P.ws + WS_CTL))[8 + h];
    f32x16 o[2]; float l; att::u32x4 gpre[4];
    att::attn_core<1, 1, 3>(lds, Zb, N1, 1280 + h * 64, 1792 + h * 64, 0, 2304 + h * 64, q0w, t_lo, 4 * qb + 3, w_lo, chunk, 0, 0.f, -1, o, m, l, 2816 + h * 64, gpre);
    const size_t row = (size_t)b * SEQ + q0w + r32;
    att::store_gated(o, 1.0f / l, gpre, (bf16*)(P.ws + WS_MIX) + row * DM + 512 + h * 64, hi);
}
__device__ __forceinline__ int queue_next(unsigned* ctr, LAS unsigned char* lds, int tid) {
    volatile LAS int* w = (volatile LAS int*)(lds + MISC_OFF);
    if (tid == 0) w[0] = (int)atomicAdd(ctr, 1u);
    __syncthreads();
    const int it = w[0];
    __syncthreads();
    return it;
}

__global__ void __launch_bounds__(NTHR, 2) trunk_fwd(Params P) {
    extern __shared__ __attribute__((aligned(16))) unsigned char lds_raw[];
    LAS unsigned char* lds = (LAS unsigned char*)lds_raw;
    const int tid = threadIdx.x, lane = tid & 63, wave = __builtin_amdgcn_readfirstlane(tid >> 6);
    const int lo = P.ph_lo, hi_ = P.ph_hi, G = gridDim.x;
    unsigned char* ws = P.ws;
#define IN(k) (lo <= (k) && (k) < hi_)
    { volatile LAS unsigned* mz = (volatile LAS unsigned*)(lds + MISC_OFF); if (tid < 64) mz[tid] = 0u; }
    __syncthreads();
    XcdBarrier bar = xcd_barrier_post((unsigned*)(ws + WS_CTL) + CW_BAR, (volatile LAS unsigned*)(lds + MISC_OFF + 64));
    if (P.ph_hi > 1000) cg::this_grid().sync();
#define SEAM(k) do { if (IN(k) && IN((k) + 1)) { xcd_barrier(bar); } } while (0)
    if (IN(0)) { p0_prologue(P, lds, tid, lane, wave); __syncthreads();
#if PROBE_REP0
        p0_prologue(P, lds, tid, lane, wave); __syncthreads();
#endif
    }
    SEAM(0);
    if (IN(1)) {
        pg8::Gemm g{(const bf16*)(ws + WS_XB), (const bf16*)(ws + WS_BT0), M, N0, DM}; pg8::StaticOrder S; S.init(M, N0, G, (int)blockIdx.x);
        pg8::EpiIn E{(bf16*)(ws + WS_Z), N0, (const float*)(ws + WS_RS0), nullptr,
                     {8, 16, 24, 32, 40, 48, 56, 64}, {1, 2, 0, 3, 1, 2, 0, 3}, {P.in[4], P.in[5], nullptr, nullptr, P.in[11], P.in[12], nullptr, nullptr}, 0, -1, -1};
        pg8::gemm_phase<pg8::EpiIn, pg8::StaticOrder, PG8_ALIGN, PG8_SP2>(lds, g, S, E);
        __syncthreads();
#if PROBE_REP1
        pg8::gemm_phase<pg8::EpiIn, pg8::StaticOrder, PG8_ALIGN, PG8_SP2>(lds, g, S, E);
        __syncthreads();
#endif
    }
    SEAM(1);
    if (IN(2)) {
        unsigned* ctr = (unsigned*)(ws + WS_CTL) + 64;
        int it = (int)blockIdx.x;
        for (;;) {
            if (it >= 1024) break;
            const int pp = it >> 6, r = it & 63;
            if (r < 16) unit_A(P, lds, r, 31 - 2 * pp, tid, lane, wave);
            else if (r < 48) unit_B(P, lds, r - 16, 15 - pp, tid, lane, wave);
            else unit_A(P, lds, r - 48, 30 - 2 * pp, tid, lane, wave);
            it = G + queue_next(ctr, lds, tid);
        }
        while (it < 1024 + LATE_W_ITEMS) { late_weight_item(P, lds, it - 1024, lane, wave); it = G + queue_next(ctr, lds, tid); }
    }
    SEAM(2);
    if (IN(3)) {
        pg8::Gemm g{(const bf16*)(ws + WS_MIX), (const bf16*)(ws + WS_BTO0), M, DM, DM}; pg8::StaticOrder S; S.init(M, DM, G, (int)blockIdx.x);
        pg8::EpiOut E{P.in[0], nullptr, nullptr, (bf16*)(ws + WS_XB), (float*)(ws + WS_SSQ)};
        pg8::gemm_phase<pg8::EpiOut, pg8::StaticOrder, false, PG8_SP2>(lds, g, S, E);
        __syncthreads();
#if PROBE_REP3
        pg8::gemm_phase<pg8::EpiOut, pg8::StaticOrder, false, PG8_SP2>(lds, g, S, E);
        __syncthreads();
#endif
    }
    SEAM(3);
    if (IN(4)) {
        pg8::Gemm g{(const bf16*)(ws + WS_XB), (const bf16*)(ws + WS_BT1), M, 3072, DM}; pg8::StaticOrder S; S.init(M, 3072, G, (int)blockIdx.x);
        pg8::EpiIn E{(bf16*)(ws + WS_Z), N1, nullptr, (const float*)(ws + WS_SSQ),
                     {8, 10, 12, 20, 28, 36, 44, 52}, {1, 2, 0, 3, 1, 2, 0, 3}, {P.in[17], P.in[18], nullptr, nullptr, P.in[20], P.in[21], nullptr, nullptr}, 0, 4, 12};
        pg8::gemm_phase<pg8::EpiIn, pg8::StaticOrder, PG8_ALIGN, PG8_SP2>(lds, g, S, E);
        __syncthreads();
    }
    SEAM(4);
    if (IN(5)) {
        unsigned* late = (unsigned*)(ws + WS_CTL) + 320;
        {
            pg8::Gemm g2{(const bf16*)(ws + WS_XB), (const bf16*)(ws + WS_BT1) + (size_t)3072 * 1024, M, 256, DM}; pg8::StaticOrder S2; S2.init(M, 256, G, (int)blockIdx.x);
            pg8::Unit u0; int n_mine = 0; while (S2.next(n_mine, u0)) ++n_mine;
            const bool mine = n_mine > 0;
            pg8::EpiIn E2{(bf16*)(ws + WS_Z), N1, nullptr, (const float*)(ws + WS_SSQ),
                          {8, 10, 12, 20, 28, 36, 44, 52}, {1, 2, 0, 3, 1, 2, 0, 3}, {P.in[17], P.in[18], nullptr, nullptr, P.in[20], P.in[21], nullptr, nullptr}, 12, 4, 12};
            pg8::gemm_phase<pg8::EpiIn, pg8::StaticOrder, PG8_ALIGN, PG8_SP2>(lds, g2, S2, E2);
            if (mine) {
                asm volatile("s_waitcnt vmcnt(0)" ::: "memory"); __syncthreads();
                if (tid == 0) { __builtin_amdgcn_fence(__ATOMIC_RELEASE, "agent"); asm volatile("s_waitcnt vmcnt(0)" ::: "memory"); (void)xb_add(late, (unsigned)n_mine); }
                __syncthreads();
            }
        }
        bool late_ok = false;
        for (int rep = 0; rep < 1 + PROBE_REP5; ++rep) {
        unsigned* ctr = (unsigned*)(ws + WS_CTL) + 128 + 128 * rep;
        for (int it = (int)blockIdx.x; it < 1024; it = G + queue_next(ctr, lds, tid)) {
            if (it < 512) { const int bh = it & 31, qb = 15 - (it >> 5); unit_D(P, lds, bh, qb, tid, lane, wave); }
            else {
                const int r = it - 512, half = r >> 8, idx = r & 255, cc = 63 - (idx >> 2), bb = idx & 3;
                if (half && !late_ok) {
                    if (tid == 0) { unsigned sp = 0; while (xb_ld(late) < 64u) { __builtin_amdgcn_s_sleep(2); if (++sp > (1u << 22)) break; }
                        __builtin_amdgcn_fence(__ATOMIC_ACQUIRE, "agent"); asm volatile("s_waitcnt vmcnt(0)" ::: "memory"); }
                    __syncthreads(); late_ok = true;
                }
                unit_C(P, lds, bb, half, cc, tid, lane, wave);
            }
        }
        }
    }
    SEAM(5);
    if (IN(6)) {
        pg8::Gemm g{(const bf16*)(ws + WS_MIX), (const bf16*)(ws + WS_BTO1), M, DM, DM}; pg8::StaticOrder S; S.init(M, DM, G, (int)blockIdx.x);
        pg8::EpiOut E{nullptr, (const bf16*)(ws + WS_XB), P.out, nullptr, nullptr};
        pg8::gemm_phase<pg8::EpiOut, pg8::StaticOrder, false, PG8_SP2>(lds, g, S, E);
    }
#undef IN
#undef SEAM
}

extern "C" void kernel_launch(void* const* d_in, const int* in_sizes, int n_in, void* d_out, int out_size, void* d_ws, size_t ws_size, hipStream_t stream) {
    static int grid = 0;
    if (grid == 0) {
        if (n_in != 23 || out_size != M * DM || ws_size < WS_END) { fprintf(stderr, "kernel_launch: unexpected shapes (n_in %d, out %d, ws %zu)\n", n_in, out_size, ws_size); grid = -1; return; }
        int dev = 0, cus = 0, per_cu = 0;
        hipGetDevice(&dev); hipDeviceGetAttribute(&cus, hipDeviceAttributeMultiprocessorCount, dev);
        if (hipFuncSetAttribute((const void*)trunk_fwd, hipFuncAttributeMaxDynamicSharedMemorySize, LDS_BYTES) != hipSuccess) { fprintf(stderr, "kernel_launch: hipFuncSetAttribute failed\n"); grid = -1; return; }
        if (hipOccupancyMaxActiveBlocksPerMultiprocessor(&per_cu, (const void*)trunk_fwd, NTHR, LDS_BYTES) != hipSuccess || per_cu < 1) { fprintf(stderr, "kernel_launch: occupancy query says %d\n", per_cu); per_cu = 1; }
        (void)hipGetLastError();
        grid = cus * 1;
        if (grid <= 0) grid = 256;
    }
    if (grid < 0) return;
    if (hipMemsetAsync((char*)d_ws + WS_CTL, 0, 65536, stream) != hipSuccess) { fprintf(stderr, "kernel_launch: memset failed\n"); return; }
    Params p{};
    for (int i = 0; i < 23; ++i) p.in[i] = (const float*)d_in[i];
    p.out = (float*)d_out; p.ws = (unsigned char*)d_ws;
#if MK_LAUNCHES == 1
    p.ph_lo = 0; p.ph_hi = 7;
    void* args[] = {&p};
    hipError_t e = hipLaunchCooperativeKernel((const void*)trunk_fwd, dim3(grid), dim3(NTHR), args, LDS_BYTES, stream);
    if (e != hipSuccess) fprintf(stderr, "kernel_launch: cooperative launch failed: %s (grid %d)\n", hipGetErrorString(e), grid);
#else
    for (int ph = 0; ph < 7; ++ph) { p.ph_lo = ph; p.ph_hi = ph + 1; hipLaunchKernelGGL(trunk_fwd, dim3(grid), dim3(NTHR), LDS_BYTES, stream, p); }
#endif
}
```

```cpp
#include <hip/hip_runtime.h>
#include <hip/hip_cooperative_groups.h>
#include <cstdio>
#include <cstdint>
namespace cg = cooperative_groups;
#ifndef PROBE_REP0
#define PROBE_REP0 0
#endif
#ifndef PROBE_REP3
#define PROBE_REP3 0
#endif
#ifndef PROBE_REP4
#define PROBE_REP4 0
#endif
#ifndef PROBE_REP1
#define PROBE_REP1 0
#endif
#ifndef PROBE_REP2
#define PROBE_REP2 0
#endif
#ifndef PROBE_REP5
#define PROBE_REP5 0
#endif
#ifndef MK_LAUNCHES
#define MK_LAUNCHES 1
#endif
namespace pg8 {
#define PG8_LAS __attribute__((address_space(3)))
typedef unsigned short bf16_t;
typedef short bf16x8 __attribute__((ext_vector_type(8)));
typedef float f32x4 __attribute__((ext_vector_type(4)));
typedef unsigned u32x4 __attribute__((ext_vector_type(4)));
constexpr int BM = 256, BK = 64, HALF = 128, HTB = HALF * BK * 2  , STAGE_BYTES = 8 * HTB, NXCD = 8, WGM = 8;

__host__ __device__ __forceinline__ int lds_byte(int r, int c) { const int st = (r >> 4) * 2 + (c >> 5), rr = r & 15, cc = c & 31, ob = rr * 64 + cc * 2; return st * 1024 + (ob ^ (((ob >> 9) & 1) << 5)); }
__host__ __device__ __forceinline__ void stage_rc(int b, int& R, int& C) { const int st = b / 1024, sb = b % 1024, swz = sb ^ (((sb >> 9) & 1) << 5); R = (st >> 1) * 16 + swz / 64; C = (st & 1) * 32 + (swz % 64) / 2; }
__host__ __device__ __forceinline__ int perm32(int rho) { const int n = rho >> 4, i = rho & 15; return 8 * (i >> 2) + 4 * n + (i & 3); }

struct Unit { int pm, pn; };
struct Gemm { const bf16_t* A; const bf16_t* Bt; int M, N, K; };

struct StaticOrder {
    int nM, nN, nwg, G, c;
    __host__ __device__ void init(int M, int N, int G_, int c_) { nM = M / BM; nN = N / BM; nwg = nM * nN; G = G_; c = c_; }
    __host__ __device__ bool next(int i, Unit& u) const {
        const long L = (long)i * G + c; if (L >= nwg) return false;
        int wgid = (int)L; { const int q = nwg / NXCD, r = nwg % NXCD, xcd = wgid % NXCD, off = wgid / NXCD; wgid = (xcd < r ? xcd * (q + 1) : r * (q + 1) + (xcd - r) * q) + off; }
        const int nig = WGM * nN, gid = wgid / nig, fm = gid * WGM, gsz = (nM - fm) < WGM ? (nM - fm) : WGM;
        u.pm = fm + ((wgid % nig) % gsz); u.pn = (wgid % nig) / gsz; return true;
    }
    __device__ __forceinline__ void a_ready(const Unit&) const {}
    __device__ __forceinline__ void done(const Unit&) const {}
};

__device__ __forceinline__ unsigned cvt_pk_bf16(float lo, float hi) { unsigned r; asm volatile("v_cvt_pk_bf16_f32 %0, %1, %2" : "=v"(r) : "v"(lo), "v"(hi)); return r; }
typedef float f32x2 __attribute__((ext_vector_type(2)));
typedef unsigned u32x2 __attribute__((ext_vector_type(2)));
constexpr float QK_C2 = 0.125f * 1.4426950408889634f;
struct EpiIn {
    static constexpr bool PERM = true, AFTER_DRAIN = false;
    bf16_t* O; int ldc; const float* rs; const float* ssq;
    int seg_end[8]; int seg_mode[8]; const float* seg_g[8];
    int pn_off, sw_a, sw_b;
    __device__ __forceinline__ void operator()(const f32x4 (&acc)[2][2][4][2], const Unit& u, int wr, int wc, int fr, int fq) const {
        int lt = u.pn + pn_off; lt = (lt == sw_a) ? sw_b : (lt == sw_b ? sw_a : lt);
        const int gidx = lt * 4 + wc;
        int mode = 0; const float* g = nullptr;
#pragma unroll
        for (int s = 7; s >= 0; --s) if (gidx < seg_end[s]) { mode = seg_mode[s]; g = seg_g[s]; }
        f32x4 gv[2][2];
#pragma unroll
        for (int bj = 0; bj < 2; ++bj)
#pragma unroll
            for (int n = 0; n < 2; ++n) gv[bj][n] = (mode == 1 || mode == 2) ? *(const f32x4*)(g + 32 * bj + 8 * fq + 4 * n) : (f32x4){1.f, 1.f, 1.f, 1.f};
        const float qs = (mode == 1) ? QK_C2 : 1.0f;
        float rr[2][4];
        if (rs) {
#pragma unroll
            for (int ai = 0; ai < 2; ++ai)
#pragma unroll
                for (int m = 0; m < 4; ++m) rr[ai][m] = rs[u.pm * BM + ai * HALF + wr * 64 + m * 16 + fr];
        }
        asm volatile("" ::: "memory");
#pragma unroll
        for (int ai = 0; ai < 2; ++ai) {
            if (!rs) {
                f32x4 sp[4][4];
#pragma unroll
                for (int m = 0; m < 4; ++m) { const f32x4* p_ = (const f32x4*)(ssq + (size_t)(u.pm * BM + ai * HALF + wr * 64 + m * 16 + fr) * 16);
#pragma unroll
                    for (int q = 0; q < 4; ++q) sp[m][q] = p_[q]; }
                asm volatile("" ::: "memory");
#pragma unroll
                for (int m = 0; m < 4; ++m) { const f32x4 a = sp[m][0], b = sp[m][1], c = sp[m][2], d = sp[m][3];
                    const float t = ((a[0] + a[1]) + (a[2] + a[3])) + ((b[0] + b[1]) + (b[2] + b[3])) + ((c[0] + c[1]) + (c[2] + c[3])) + ((d[0] + d[1]) + (d[2] + d[3]));
                    rr[ai][m] = __builtin_amdgcn_rsqf(t * (1.0f / 1024.0f) + 1e-6f); }
            }
#pragma unroll
            for (int m = 0; m < 4; ++m) {
                const int row = u.pm * BM + ai * HALF + wr * 64 + m * 16 + fr;
                const float r = rr[ai][m];
                f32x4 v[2][2];
#pragma unroll
                for (int bj = 0; bj < 2; ++bj)
#pragma unroll
                    for (int n = 0; n < 2; ++n) v[bj][n] = acc[ai][bj][m][n] * r;
                if (mode == 1 || mode == 2) {
                    float ss = 0.f;
#pragma unroll
                    for (int bj = 0; bj < 2; ++bj)
#pragma unroll
                        for (int n = 0; n < 2; ++n) { const f32x4 x = v[bj][n]; ss += (x[0] * x[0] + x[1] * x[1]) + (x[2] * x[2] + x[3] * x[3]); }
                    ss += __shfl_xor(ss, 16); ss += __shfl_xor(ss, 32);
                    const float rn = qs * __builtin_amdgcn_rsqf(ss * (1.0f / 64.0f) + 1e-6f);
#pragma unroll
                    for (int bj = 0; bj < 2; ++bj)
#pragma unroll
                        for (int n = 0; n < 2; ++n) v[bj][n] = v[bj][n] * rn * gv[bj][n];
                } else if (mode == 3) {
#pragma unroll
                    for (int bj = 0; bj < 2; ++bj)
#pragma unroll
                        for (int n = 0; n < 2; ++n)
#pragma unroll
                            for (int e = 0; e < 4; ++e) { const float x = v[bj][n][e]; v[bj][n][e] = x * __builtin_amdgcn_rcpf(1.0f + __builtin_amdgcn_exp2f(x * -1.4426950408889634f)); }
                }
                bf16_t* rowp = O + (size_t)row * ldc + lt * BM + wc * 64 + 8 * fq;
#pragma unroll
                for (int bj = 0; bj < 2; ++bj) { u32x4 w; w.x = cvt_pk_bf16(v[bj][0][0], v[bj][0][1]); w.y = cvt_pk_bf16(v[bj][0][2], v[bj][0][3]); w.z = cvt_pk_bf16(v[bj][1][0], v[bj][1][1]); w.w = cvt_pk_bf16(v[bj][1][2], v[bj][1][3]);
                    *(u32x4*)(rowp + bj * 32) = w; }
            }
        }
    }
};
struct EpiOut {
    static constexpr bool PERM = true, AFTER_DRAIN = false;
    const float* base; const bf16_t* base16; float* out; bf16_t* xb; float* ssq;
    __device__ __forceinline__ void operator()(const f32x4 (&acc)[2][2][4][2], const Unit& u, int wr, int wc, int fr, int fq) const {
        const int col0 = u.pn * BM + wc * 32 + 8 * fq;
#pragma unroll
        for (int ai = 0; ai < 2; ++ai) {
            f32x4 pre[4][2][2];
#pragma unroll
            for (int m = 0; m < 4; ++m) { const size_t off = (size_t)(u.pm * BM + ai * HALF + wr * 64 + m * 16 + fr) * 1024 + col0;
#pragma unroll
                for (int bj = 0; bj < 2; ++bj) {
                    if (base16) { const u32x4 w = *(const u32x4*)(base16 + off + bj * HALF);
                        pre[m][bj][0] = (f32x4){__uint_as_float(w.x << 16), __uint_as_float(w.x & 0xffff0000u), __uint_as_float(w.y << 16), __uint_as_float(w.y & 0xffff0000u)};
                        pre[m][bj][1] = (f32x4){__uint_as_float(w.z << 16), __uint_as_float(w.z & 0xffff0000u), __uint_as_float(w.w << 16), __uint_as_float(w.w & 0xffff0000u)}; }
                    else { pre[m][bj][0] = *(const f32x4*)(base + off + bj * HALF); pre[m][bj][1] = *(const f32x4*)(base + off + bj * HALF + 4); } } }
            asm volatile("" ::: "memory");
#pragma unroll
            for (int m = 0; m < 4; ++m) {
                const int row = u.pm * BM + ai * HALF + wr * 64 + m * 16 + fr;
                const size_t off = (size_t)row * 1024 + col0;
                float ss = 0.f;
#pragma unroll
                for (int bj = 0; bj < 2; ++bj) {
                    const f32x4 o0 = pre[m][bj][0] + acc[ai][bj][m][0], o1 = pre[m][bj][1] + acc[ai][bj][m][1];
                    if (out) { *(f32x4*)(out + off + bj * HALF) = o0; *(f32x4*)(out + off + bj * HALF + 4) = o1; }
                    ss += (o0[0] * o0[0] + o0[1] * o0[1]) + (o0[2] * o0[2] + o0[3] * o0[3]) + (o1[0] * o1[0] + o1[1] * o1[1]) + (o1[2] * o1[2] + o1[3] * o1[3]);
                    if (xb) { u32x4 w; w.x = cvt_pk_bf16(o0[0], o0[1]); w.y = cvt_pk_bf16(o0[2], o0[3]); w.z = cvt_pk_bf16(o1[0], o1[1]); w.w = cvt_pk_bf16(o1[2], o1[3]);
                        *(u32x4*)(xb + off + bj * HALF) = w; }
                }
                if (ssq) { ss += __shfl_xor(ss, 16); ss += __shfl_xor(ss, 32); if (fq == 0) ssq[(size_t)row * 16 + u.pn * 4 + wc] = ss; }
            }
            asm volatile("" ::: "memory");
        }
    }
};

template <class Epi, class Sched, bool ALIGN_EPI = false, bool SP2 = false>
__device__ __forceinline__ void gemm_phase(PG8_LAS unsigned char* lds, const Gemm g, const Sched& S, const Epi& E) {
    const int tid = threadIdx.x, wid = __builtin_amdgcn_readfirstlane(tid >> 6), lane = tid & 63, wr = wid >> 2, wc = wid & 3, fr = lane & 15, fq = lane >> 4;
    const int K = g.K, nt = K / BK;
    unsigned voffA[2], voffB[2];
#pragma unroll
    for (int i = 0; i < 2; ++i) { int R, C; stage_rc(tid * 16 + i * 8192, R, C); const int Rb = Epi::PERM ? ((R & ~31) + perm32(R & 31)) : R;
        voffA[i] = (unsigned)(R * K + C) * 2u; voffB[i] = (unsigned)(Rb * K + C) * 2u; }
    const size_t kstep = (size_t)(BK * 2);
    const size_t hstep = (size_t)HALF * K * 2;
    const size_t tstep = 2 * hstep;
    const unsigned ldsw = (unsigned)wid * 1024u;
    const int aoff = lds_byte(wr * 64 + fr, fq * 8), boff = lds_byte(wc * 32 + fr, fq * 8);
#define PG8_SA(b, h) (((b) * 2 + (h)) * HTB)
#define PG8_SB(b, h) ((4 + (b) * 2 + (h)) * HTB)
#define PG8_STAGE(bufoff, gbase, voff) do { _Pragma("unroll") for (int _i = 0; _i < 2; ++_i) \
        __builtin_amdgcn_global_load_lds((const unsigned*)((const char*)(gbase) + (voff)[_i]), (PG8_LAS unsigned*)(lds + (bufoff) + ldsw + _i * 8192), 16, 0, 0); } while (0)
#define PG8_LDA(dst, b, h) do { _Pragma("unroll") for (int m = 0; m < 4; ++m) _Pragma("unroll") for (int k = 0; k < 2; ++k) dst[m][k] = *(const PG8_LAS bf16x8*)(lds + PG8_SA(b, h) + aoff + m * 2048 + k * 1024); } while (0)
#define PG8_LDB(dst, b, h) do { _Pragma("unroll") for (int n = 0; n < 2; ++n) _Pragma("unroll") for (int k = 0; k < 2; ++k) dst[n][k] = *(const PG8_LAS bf16x8*)(lds + PG8_SB(b, h) + boff + n * 2048 + k * 1024); } while (0)
#define PG8_MMA(ai, bj, At, Bt) do { __builtin_amdgcn_s_setprio(1); _Pragma("unroll") for (int m = 0; m < 4; ++m) _Pragma("unroll") for (int n = 0; n < 2; ++n) _Pragma("unroll") for (int k = 0; k < 2; ++k) \
        acc[ai][bj][m][n] = __builtin_amdgcn_mfma_f32_16x16x32_bf16(Bt[n][k], At[m][k], acc[ai][bj][m][n], 0, 0, 0); __builtin_amdgcn_s_setprio(0); } while (0)
#define PG8_WAIT_V(n) asm volatile("s_waitcnt vmcnt(" #n ")" ::: "memory")
#define PG8_WAIT_L(n) asm volatile("s_waitcnt lgkmcnt(" #n ")" ::: "memory")
#define PG8_BAR __builtin_amdgcn_s_barrier()
#define PG8_SCHED __builtin_amdgcn_sched_barrier(0)
    Unit cur, nxt; int ui = 0;
    if (!S.next(0, cur)) return;
    f32x4 acc[2][2][4][2];
#pragma unroll
    for (int a = 0; a < 2; ++a)
#pragma unroll
        for (int b = 0; b < 2; ++b)
#pragma unroll
            for (int m = 0; m < 4; ++m)
#pragma unroll
                for (int n = 0; n < 2; ++n) acc[a][b][m][n] = (f32x4){0.f, 0.f, 0.f, 0.f};
    bf16x8 At[4][2], B0[2][2], B1[2][2];
    const char* cA = (const char*)g.A + (size_t)cur.pm * tstep; const char* cB = (const char*)g.Bt + (size_t)cur.pn * tstep;
    S.a_ready(cur);
    if constexpr (SP2) {
        PG8_STAGE(PG8_SB(0, 0), cB, voffB); PG8_STAGE(PG8_SB(0, 1), cB + hstep, voffB); PG8_STAGE(PG8_SA(0, 0), cA, voffA); PG8_STAGE(PG8_SA(0, 1), cA + hstep, voffA);
        if (wr == 1) PG8_BAR;
        PG8_WAIT_V(2); PG8_BAR;
        PG8_STAGE(PG8_SB(1, 0), cB + kstep, voffB); PG8_STAGE(PG8_SA(1, 0), cA + kstep, voffA); PG8_STAGE(PG8_SB(1, 1), cB + hstep + kstep, voffB);
        PG8_WAIT_V(6); PG8_BAR;
    } else {
        PG8_STAGE(PG8_SB(0, 0), cB, voffB); PG8_STAGE(PG8_SA(0, 0), cA, voffA); PG8_STAGE(PG8_SB(0, 1), cB + hstep, voffB); PG8_STAGE(PG8_SA(0, 1), cA + hstep, voffA);
        if (wr == 1) PG8_BAR;
        PG8_WAIT_V(4); PG8_BAR;
        PG8_STAGE(PG8_SB(1, 0), cB + kstep, voffB); PG8_STAGE(PG8_SA(1, 0), cA + kstep, voffA); PG8_STAGE(PG8_SB(1, 1), cB + hstep + kstep, voffB);
        PG8_WAIT_V(6); PG8_BAR;
    }
    for (;;) {
        const bool has_next = S.next(ui + 1, nxt);
        const char* nA = has_next ? (const char*)g.A + (size_t)nxt.pm * tstep : cA; const char* nB = has_next ? (const char*)g.Bt + (size_t)nxt.pn * tstep : cB;
        for (int t = 0; t < nt; t += 2) {
            const bool last = (t == nt - 2);
            const char* a1 = cA + (size_t)(t + 1) * kstep;
            const char* a2 = last ? nA : cA + (size_t)(t + 2) * kstep; const char* b2 = last ? nB : cB + (size_t)(t + 2) * kstep;
            const char* a3 = a2 + kstep; const char* b3 = b2 + kstep;
            if (last && has_next) S.a_ready(nxt);
            if constexpr (SP2) {
            PG8_LDB(B0, 0, 0); PG8_LDB(B1, 0, 1); PG8_SCHED; PG8_LDA(At, 0, 0); PG8_STAGE(PG8_SA(1, 1), a1 + hstep, voffA);
            PG8_WAIT_V(8); PG8_WAIT_L(0); PG8_BAR; PG8_MMA(0, 0, At, B0); PG8_MMA(0, 1, At, B1); PG8_BAR; PG8_SCHED;
            PG8_LDA(At, 0, 1); PG8_STAGE(PG8_SB(0, 0), b2, voffB); PG8_STAGE(PG8_SB(0, 1), b2 + hstep, voffB); PG8_STAGE(PG8_SA(0, 0), a2, voffA);
            PG8_WAIT_V(8); PG8_WAIT_L(0); PG8_BAR; PG8_MMA(1, 0, At, B0); PG8_MMA(1, 1, At, B1); PG8_BAR; PG8_SCHED;
            PG8_LDB(B0, 1, 0); PG8_LDB(B1, 1, 1); PG8_SCHED; PG8_LDA(At, 1, 0); PG8_STAGE(PG8_SA(0, 1), a2 + hstep, voffA);
            PG8_WAIT_V(8); PG8_WAIT_L(0); PG8_BAR; PG8_MMA(0, 0, At, B0); PG8_MMA(0, 1, At, B1); PG8_BAR; PG8_SCHED;
            PG8_LDA(At, 1, 1); PG8_STAGE(PG8_SB(1, 0), b3, voffB); PG8_STAGE(PG8_SB(1, 1), b3 + hstep, voffB); PG8_STAGE(PG8_SA(1, 0), a3, voffA);
            PG8_WAIT_V(8); PG8_WAIT_L(0); PG8_BAR; PG8_MMA(1, 0, At, B0); PG8_MMA(1, 1, At, B1); PG8_BAR; PG8_SCHED;
            } else {
            PG8_LDB(B0, 0, 0); PG8_SCHED; PG8_LDA(At, 0, 0); PG8_STAGE(PG8_SA(1, 1), a1 + hstep, voffA);
            PG8_WAIT_L(8); PG8_BAR; PG8_WAIT_L(0); PG8_MMA(0, 0, At, B0); PG8_BAR; PG8_SCHED;
            PG8_LDB(B1, 0, 1); PG8_STAGE(PG8_SB(0, 0), b2, voffB);
            PG8_BAR; PG8_WAIT_L(0); PG8_MMA(0, 1, At, B1); PG8_BAR;
            PG8_LDA(At, 0, 1); PG8_STAGE(PG8_SA(0, 0), a2, voffA);
            PG8_BAR; PG8_WAIT_L(0); PG8_MMA(1, 0, At, B0); PG8_BAR; PG8_SCHED;
            PG8_STAGE(PG8_SB(0, 1), b2 + hstep, voffB);
            PG8_WAIT_V(6); PG8_BAR; PG8_MMA(1, 1, At, B1); PG8_BAR;
            PG8_LDB(B0, 1, 0); PG8_SCHED; PG8_LDA(At, 1, 0); PG8_STAGE(PG8_SA(0, 1), a2 + hstep, voffA);
            PG8_WAIT_L(8); PG8_BAR; PG8_WAIT_L(0); PG8_MMA(0, 0, At, B0); PG8_BAR; PG8_SCHED;
            PG8_LDB(B1, 1, 1); PG8_STAGE(PG8_SB(1, 0), b3, voffB);
            PG8_BAR; PG8_WAIT_L(0); PG8_MMA(0, 1, At, B1); PG8_BAR;
            PG8_LDA(At, 1, 1); PG8_STAGE(PG8_SA(1, 0), a3, voffA);
            PG8_BAR; PG8_WAIT_L(0); PG8_MMA(1, 0, At, B0); PG8_BAR; PG8_SCHED;
            PG8_STAGE(PG8_SB(1, 1), b3 + hstep, voffB);
            PG8_WAIT_V(6); PG8_BAR; PG8_MMA(1, 1, At, B1); PG8_BAR;
            }
        }
        if constexpr (ALIGN_EPI) { if (wr == 0) PG8_BAR; }
        if constexpr (!Epi::AFTER_DRAIN) { E(acc, cur, wr, wc, fr, fq); S.done(cur); }
        if (!has_next) break;
#pragma unroll
        for (int a = 0; a < 2; ++a)
#pragma unroll
            for (int b = 0; b < 2; ++b)
#pragma unroll
                for (int m = 0; m < 4; ++m)
#pragma unroll
                    for (int n = 0; n < 2; ++n) acc[a][b][m][n] = (f32x4){0.f, 0.f, 0.f, 0.f};
        cur = nxt; cA = nA; cB = nB; ++ui;
        if constexpr (ALIGN_EPI) { if (wr == 1) PG8_BAR; }
    }
    PG8_WAIT_V(0);
    if constexpr (!ALIGN_EPI) { if (wr == 0) PG8_BAR; }
    PG8_BAR;
    if constexpr (Epi::AFTER_DRAIN) { E.fused(acc, cur, wr, wc, fr, fq, lds, wid, lane); S.done(cur); }
#undef PG8_SA
#undef PG8_SB
#undef PG8_STAGE
#undef PG8_LDA
#undef PG8_LDB
#undef PG8_MMA
#undef PG8_WAIT_V
#undef PG8_WAIT_L
#undef PG8_BAR
#undef PG8_SCHED
}
}
#define PG8_SP2 true
#define PG8_ALIGN true
namespace att {
typedef unsigned short bf16_t;
typedef __attribute__((address_space(3))) unsigned char* lptr;
typedef __attribute__((address_space(3))) const unsigned char* lcptr;
typedef short bf16x8 __attribute__((ext_vector_type(8)));
typedef short s16x4 __attribute__((ext_vector_type(4)));
typedef float f32x16 __attribute__((ext_vector_type(16)));
typedef float f32x4 __attribute__((ext_vector_type(4)));
typedef unsigned u32x4 __attribute__((ext_vector_type(4)));
typedef unsigned u32x2 __attribute__((ext_vector_type(2)));
typedef float f32x2_t __attribute__((ext_vector_type(2)));
typedef __bf16 bf16x2_t __attribute__((ext_vector_type(2)));
constexpr float LOG2E = 1.4426950408889634f;
constexpr int SLOT = 32768, LDS_CUM = 65536, LDS_TAB = 81920;
__device__ __forceinline__ unsigned cvtpk(float lo, float hi) { f32x2_t v = {lo, hi}; bf16x2_t b = __builtin_convertvector(v, bf16x2_t); return __builtin_bit_cast(unsigned, b); }
__device__ __forceinline__ float bf2f(unsigned short h) { return __uint_as_float(((unsigned)h) << 16); }
__device__ __forceinline__ void glds16(const void* gsrc, unsigned lds_dst) { unsigned keep;
    asm volatile("s_mov_b32 %0, m0\n\ts_mov_b32 m0, %2\n\ts_nop 0\n\tglobal_load_lds_dwordx4 %1, off\n\ts_mov_b32 m0, %0" : "=&s"(keep) : "v"(gsrc), "s"(lds_dst) : "memory"); }
__device__ __forceinline__ float fadd_s(float a, float b) { return a + b; }
__device__ __forceinline__ float fsub_s(float a, float b) { return a - b; }
__device__ __forceinline__ s16x4 vtr(lcptr p) { return __builtin_bit_cast(s16x4, __builtin_amdgcn_ds_read_tr16_b64_v4i16((__attribute__((address_space(3))) s16x4*)p)); }

template <int VD, int NK, int MODE>
__device__ __forceinline__ void attn_core(lptr lds, const bf16_t* Zb, int ldz, int qcol, int kcol0, int kcol1, int vcol, int q0w,
                                          int t_lo, int t_hi, int w_lo, int w_hi, int ksel, float nsl, int diag_t,
                                          f32x16 (&o)[2 * VD], float mref, float& l_run, int gcol, u32x4 (&gpre)[4]) {
    const int tid = threadIdx.x, lane = tid & 63, r32 = lane & 31, hi = lane >> 5;
    const int wv_ = __builtin_amdgcn_readfirstlane(tid >> 6);
    const int krow_ = 8 * wv_ + (lane >> 3), kchk_ = (lane & 7) ^ ((krow_ >> 1) & 7);
    const bf16_t* ksrc0 = Zb + (size_t)krow_ * ldz + kcol0 + kchk_ * 8;
    const bf16_t* ksrc1 = Zb + (size_t)krow_ * ldz + kcol1 + kchk_ * 8;
    const bf16_t* vsrc = Zb + (size_t)krow_ * ldz + vcol + ((lane & 7) ^ (4 * ((lane >> 4) & 1))) * 8;
    const unsigned lds0 = (unsigned)(uintptr_t)lds + (unsigned)wv_ * 1024u;
#define ATT_DMA(t, sl) do { const size_t go_ = (size_t)(t) * 64 * ldz; const unsigned d_ = (unsigned)__builtin_amdgcn_readfirstlane(lds0 + (unsigned)(sl) * SLOT); \
        glds16(ksrc0 + go_, d_); if (NK == 2) glds16(ksrc1 + go_, d_ + 8192u); glds16(vsrc + go_, d_ + 16384u); if (VD == 2) glds16(vsrc + go_ + 64, d_ + 24576u); } while (0)
#define ATT_DMA_WAIT() asm volatile("s_waitcnt vmcnt(0)" ::: "memory")
    bf16x8 qr[4];
    { const bf16_t* qp = Zb + (size_t)(q0w + r32) * ldz + qcol + hi * 8;
#pragma unroll
      for (int d0 = 0; d0 < 4; ++d0) qr[d0] = *(const bf16x8*)(qp + d0 * 16); }
#pragma unroll
    for (int i = 0; i < 2 * VD; ++i) o[i] = f32x16{};
    const float m = mref; float l = 0.f;
    const int qabs = q0w + r32;
    unsigned koff[4];
#pragma unroll
    for (int d0 = 0; d0 < 4; ++d0) koff[d0] = (unsigned)(ksel * 8192 + r32 * 128 + (((2 * d0 + hi) ^ ((r32 >> 1) & 7)) << 4));
    unsigned vfr[2];
#pragma unroll
    for (int dh = 0; dh < 2; ++dh) vfr[dh] = (unsigned)(16384 + (4 * hi + ((lane & 15) >> 2)) * 128 + ((dh ^ ((lane >> 3) & 1)) * 64) + ((lane >> 4) & 1) * 32 + (lane & 3) * 8);
    if (gcol >= 0) {
        const bf16_t* gp = Zb + (size_t)(q0w + r32) * ldz + gcol + 8 * hi;
#pragma unroll
        for (int i = 0; i < 4; ++i) gpre[i] = *(const u32x4*)(gp + 32 * (i >> 1) + 16 * (i & 1));
    }
    ATT_DMA(t_lo, 0); ATT_DMA_WAIT();
    if (gcol >= 0) asm volatile("" : "+v"(gpre[0]), "+v"(gpre[1]), "+v"(gpre[2]), "+v"(gpre[3]));
    __syncthreads();
    const float nnsl = -nsl;
    for (int t = t_lo; t <= t_hi; ++t) {
        const int cur = (t - t_lo) & 1;
        const bool act_ = (t >= w_lo && t <= w_hi);
        if (!act_) { if (t < t_hi) ATT_DMA(t + 1, cur ^ 1); }
        if (act_) {
            lcptr sb = (lcptr)(lds + cur * SLOT);
            bf16x8 kf[8];
#pragma unroll
            for (int d0 = 0; d0 < 4; ++d0) { kf[2 * d0] = *(const __attribute__((address_space(3))) bf16x8*)(sb + koff[d0]); kf[2 * d0 + 1] = *(const __attribute__((address_space(3))) bf16x8*)(sb + koff[d0] + 4096); }
            s16x4 vlo[8], vhh[8];
#pragma unroll
            for (int i = 0; i < 8; ++i) { vlo[i] = vtr(sb + vfr[i >> 2] + (i & 3) * 2048); vhh[i] = vtr(sb + vfr[i >> 2] + (i & 3) * 2048 + 1024); }
            __builtin_amdgcn_sched_barrier(0);
            f32x16 p0, p1;
            if (MODE == 0 || MODE == 2) {
                const float fq = (float)(qabs - 64 * t - 4 * hi);
                if (t == w_hi) {
#pragma unroll
                    for (int r = 0; r < 16; ++r) { const float c = (float)((r & 3) + 8 * (r >> 2));
                        p0[r] = __builtin_fmaf(nsl, __builtin_fabsf(fq - c), -m); p1[r] = __builtin_fmaf(nsl, __builtin_fabsf(fq - c - 32.0f), -m); }
                } else {
                    const float sh = __builtin_fmaf(nsl, fq, -m), n8 = 8.0f * nnsl, n32 = 32.0f * nnsl;
                    float bj_ = sh;
#pragma unroll
                    for (int j = 0; j < 4; ++j) { p0[4 * j] = bj_; p0[4 * j + 1] = fadd_s(p0[4 * j], nnsl); p0[4 * j + 2] = fadd_s(p0[4 * j + 1], nnsl); p0[4 * j + 3] = fadd_s(p0[4 * j + 2], nnsl);
                        if (j < 3) bj_ = fadd_s(bj_, n8); }
#pragma unroll
                    for (int r = 0; r < 16; ++r) p1[r] = fadd_s(p0[r], n32);
                }
            } else if (MODE == 1) {
                const __attribute__((address_space(3))) float* cl = (const __attribute__((address_space(3))) float*)(lds + LDS_CUM) + 64 * t + 4 * hi;
#pragma unroll
                for (int j = 0; j < 4; ++j) { const f32x4 c0 = *(const __attribute__((address_space(3))) f32x4*)(cl + 8 * j), c1 = *(const __attribute__((address_space(3))) f32x4*)(cl + 8 * j + 32);
#pragma unroll
                    for (int e = 0; e < 4; ++e) { p0[4 * j + e] = fsub_s(c0[e], m); p1[4 * j + e] = fsub_s(c1[e], m); } }
            } else {
                const __attribute__((address_space(3))) float* tb = (const __attribute__((address_space(3))) float*)(lds + LDS_TAB) + (575 - (qabs - 64 * t - 4 * hi));
#pragma unroll
                for (int r = 0; r < 16; ++r) { const int c = (r & 3) + 8 * (r >> 2); p0[r] = tb[c]; p1[r] = tb[c + 32]; }
            }
#pragma unroll
            for (int d0 = 0; d0 < 4; ++d0) {
                p0 = __builtin_amdgcn_mfma_f32_32x32x16_bf16(kf[2 * d0], qr[d0], p0, 0, 0, 0);
                p1 = __builtin_amdgcn_mfma_f32_32x32x16_bf16(kf[2 * d0 + 1], qr[d0], p1, 0, 0, 0);
            }
            if (t < t_hi) ATT_DMA(t + 1, cur ^ 1);

            if (MODE == 1) { if (t == diag_t) { const int qrel = (qabs & 63) - 4 * hi;
#pragma unroll
                    for (int r = 0; r < 16; ++r) { const int kv = (r & 3) + 8 * (r >> 2); if (kv > qrel) p0[r] = -INFINITY; if (kv + 32 > qrel) p1[r] = -INFINITY; } } }
            float sa = 0.f, sb_ = 0.f;
#pragma unroll
            for (int r = 0; r < 16; ++r) { p0[r] = __builtin_amdgcn_exp2f(p0[r]); p1[r] = __builtin_amdgcn_exp2f(p1[r]); sa = fadd_s(sa, p0[r]); sb_ = fadd_s(sb_, p1[r]); }
            l += sa + sb_;
            u32x4 pw[4];
            pw[0] = (u32x4){cvtpk(p0[0], p0[1]), cvtpk(p0[2], p0[3]), cvtpk(p0[4], p0[5]), cvtpk(p0[6], p0[7])};
            pw[1] = (u32x4){cvtpk(p0[8], p0[9]), cvtpk(p0[10], p0[11]), cvtpk(p0[12], p0[13]), cvtpk(p0[14], p0[15])};
            pw[2] = (u32x4){cvtpk(p1[0], p1[1]), cvtpk(p1[2], p1[3]), cvtpk(p1[4], p1[5]), cvtpk(p1[6], p1[7])};
            pw[3] = (u32x4){cvtpk(p1[8], p1[9]), cvtpk(p1[10], p1[11]), cvtpk(p1[12], p1[13]), cvtpk(p1[14], p1[15])};
#pragma unroll
            for (int i = 0; i < 8; ++i) { const bf16x8 vf = (bf16x8){vlo[i][0], vlo[i][1], vlo[i][2], vlo[i][3], vhh[i][0], vhh[i][1], vhh[i][2], vhh[i][3]};
                o[i >> 2] = __builtin_amdgcn_mfma_f32_32x32x16_bf16(vf, __builtin_bit_cast(bf16x8, pw[i & 3]), o[i >> 2], 0, 0, 0); }
            if (VD == 2) {
#pragma unroll
                for (int i = 0; i < 8; ++i) { const s16x4 lo = vtr(sb + vfr[i >> 2] + 8192 + (i & 3) * 2048), hh = vtr(sb + vfr[i >> 2] + 8192 + (i & 3) * 2048 + 1024);
                    const bf16x8 vf = (bf16x8){lo[0], lo[1], lo[2], lo[3], hh[0], hh[1], hh[2], hh[3]};
                    o[2 + (i >> 2)] = __builtin_amdgcn_mfma_f32_32x32x16_bf16(vf, __builtin_bit_cast(bf16x8, pw[i & 3]), o[2 + (i >> 2)], 0, 0, 0); }
            }
        }
        ATT_DMA_WAIT();
        __syncthreads();
    }
    { auto rr = __builtin_amdgcn_permlane32_swap(__float_as_uint(l), __float_as_uint(l), false, false); l = __uint_as_float(rr[0]) + __uint_as_float(rr[1]); }
    l_run = l;
#undef ATT_DMA
#undef ATT_DMA_WAIT
}
__device__ __forceinline__ void store_gated(const f32x16 (&o)[2], float inv, const u32x4 (&gpre)[4], bf16_t* orow, int hi) {
#pragma unroll
    for (int dh = 0; dh < 2; ++dh)
#pragma unroll
        for (int jp = 0; jp < 2; ++jp) {
            const int cb = 32 * dh + 16 * jp + 8 * hi;
            const u32x4 L = gpre[dh * 2 + jp];
            const auto g0 = __builtin_amdgcn_permlane32_swap(L.x, L.z, false, false), g1 = __builtin_amdgcn_permlane32_swap(L.y, L.w, false, false);
            u32x2 w[2];
#pragma unroll
            for (int q = 0; q < 2; ++q) { const int j = 2 * jp + q; const unsigned gx = q ? g0[1] : g0[0], gy = q ? g1[1] : g1[0];
                const float a0 = __uint_as_float(gx << 16), a1 = __uint_as_float(gx & 0xffff0000u), a2 = __uint_as_float(gy << 16), a3 = __uint_as_float(gy & 0xffff0000u);
                w[q].x = cvtpk(o[dh][4 * j] * inv * a0, o[dh][4 * j + 1] * inv * a1); w[q].y = cvtpk(o[dh][4 * j + 2] * inv * a2, o[dh][4 * j + 3] * inv * a3); }
            const auto s0 = __builtin_amdgcn_permlane32_swap(w[0].x, w[1].x, false, false), s1 = __builtin_amdgcn_permlane32_swap(w[0].y, w[1].y, false, false);
            *(u32x4*)(orow + cb) = (u32x4){s0[0], s1[0], s0[1], s1[1]};
        }
}
}
typedef unsigned short bf16;
typedef float f32x4 __attribute__((ext_vector_type(4)));
typedef float f32x16 __attribute__((ext_vector_type(16)));
typedef unsigned v4u __attribute__((ext_vector_type(4)));
typedef unsigned v2u __attribute__((ext_vector_type(2)));
#define LAS __attribute__((address_space(3)))
constexpr int NWAVES = 8, NTHR = 512;
constexpr int M = 16384, DM = 1024, SEQ = 4096;
constexpr int N0 = 4096, LDW0 = 4104, N1 = 3328;
constexpr size_t MiB = 1u << 20;
constexpr size_t WS_CTL = 0, WS_BT0 = 2 * MiB, WS_BTO0 = 10 * MiB, WS_BT1 = 12 * MiB, WS_BTO1 = 19 * MiB, WS_RS0 = 21 * MiB, WS_LF = 22 * MiB, WS_SSQ = 24 * MiB,
                 WS_XB = 32 * MiB, WS_Z = 64 * MiB, WS_MIX = 192 * MiB, WS_END = 224 * MiB;
constexpr int RING_BYTES = 131072, MISC_OFF = RING_BYTES, LDS_BYTES = RING_BYTES + 4096;
constexpr float LOG2E = 1.4426950408889634f;
constexpr int CW_BAR = 4096;

__device__ __forceinline__ unsigned f2bf(float f) { unsigned u = __builtin_bit_cast(unsigned, f); return (u + 0x7fffu + ((u >> 16) & 1u)) >> 16; }
__device__ __forceinline__ unsigned pk2(float lo, float hi) { return f2bf(lo) | (f2bf(hi) << 16); }
__device__ __forceinline__ float wave_sum(float v) {
#pragma unroll
    for (int o = 1; o < 64; o <<= 1) v += __shfl_xor(v, o);
    return v;
}
__device__ __forceinline__ void p0_transpose_item(const float* W, int ldw, int N, const float* gain, bool permute, int swa, int swb, bf16* WT, LAS float* scr, int item, int lane) {
    const int nblk = N / 32, kb = item / nblk, nb = item % nblk, k0 = 64 * kb, n0 = 32 * nb;
    float wv[32];
#pragma unroll
    for (int i = 0; i < 32; ++i) { const int kk = 2 * i + (lane >> 5); wv[i] = __builtin_nontemporal_load(W + (size_t)(k0 + kk) * ldw + n0 + (lane & 31)); }
    const float gl = gain ? gain[k0 + lane] : 1.0f;
#pragma unroll
    for (int i = 0; i < 32; ++i) { const int kk = 2 * i + (lane >> 5); scr[kk * 33 + (lane & 31)] = wv[i] * __shfl(gl, kk); }
    asm volatile("s_waitcnt lgkmcnt(0)" ::: "memory");
    const int c = lane & 7;
#pragma unroll
    for (int j = 0; j < 4; ++j) { const int n = (lane >> 3) + 8 * j; const LAS float* s = scr + (8 * c) * 33 + n;
        v4u o; o.x = pk2(s[0 * 33], s[1 * 33]); o.y = pk2(s[2 * 33], s[3 * 33]); o.z = pk2(s[4 * 33], s[5 * 33]); o.w = pk2(s[6 * 33], s[7 * 33]);
        int nl = n0 + n;
        if (permute) { int tile = nl >> 8; tile = (tile == swa) ? swb : (tile == swb ? swa : tile);
            const int t = nl & 255; nl = (tile << 8) | (((t >> 5) & 1) << 7) | (((t >> 6) & 3) << 5) | (t & 31); }
        *(v4u*)(WT + (size_t)nl * 1024 + k0 + 8 * c) = o; }
    asm volatile("s_waitcnt lgkmcnt(0)" ::: "memory");
}

struct Params { const float* in[23]; float* out; unsigned char* ws; int ph_lo, ph_hi; };

__device__ __forceinline__ void p0_prologue(const Params& P, LAS unsigned char* lds, int tid, int lane, int wave) {
    const int G = gridDim.x, gw = blockIdx.x * NWAVES + wave, NGW = G * NWAVES;
    unsigned char* ws = P.ws;
    LAS float* wf = (LAS float*)(lds + 98304);
    { float t0[16], t1[16];
#pragma unroll
      for (int u = 0; u < 16; ++u) { const int i = tid + NTHR * u, k = i >> 3, j = i & 7; t0[u] = P.in[1][k]; t1[u] = P.in[2][(size_t)k * LDW0 + N0 + j]; }
#pragma unroll
      for (int u = 0; u < 16; ++u) { const int i = tid + NTHR * u, k = i >> 3, j = i & 7; wf[j * 1024 + k] = t0[u] * t1[u]; } }
    LAS float* scr = (LAS float*)(lds + wave * 8704);
    constexpr int I0 = 16 * (N0 / 32);
    for (int it = gw; it < I0; it += NGW) p0_transpose_item(P.in[2], LDW0, N0, P.in[1], true, -1, -1, (bf16*)(ws + WS_BT0), scr, it, lane);
    __syncthreads();
    const float* x = P.in[0]; bf16* xb = (bf16*)(ws + WS_XB); float* rs0 = (float*)(ws + WS_RS0); float* lf = (float*)(ws + WS_LF);
    f32x4 vn[4];
    if (gw < M) { const f32x4* xr = (const f32x4*)(x + (size_t)gw * DM) + lane;
#pragma unroll
        for (int j = 0; j < 4; ++j) vn[j] = __builtin_nontemporal_load(xr + 64 * j); }
    for (int mrow = gw; mrow < M; mrow += NGW) {
        f32x4 v[4];
#pragma unroll
        for (int j = 0; j < 4; ++j) v[j] = vn[j];
        if (mrow + NGW < M) { const f32x4* xr = (const f32x4*)(x + (size_t)(mrow + NGW) * DM) + lane;
#pragma unroll
            for (int j = 0; j < 4; ++j) vn[j] = __builtin_nontemporal_load(xr + 64 * j); }
        float s = 0.f; float dj[8];
#pragma unroll
        for (int j = 0; j < 8; ++j) dj[j] = 0.f;
#pragma unroll
        for (int j = 0; j < 4; ++j) { s += (v[j][0] * v[j][0] + v[j][1] * v[j][1]) + (v[j][2] * v[j][2] + v[j][3] * v[j][3]);
#pragma unroll
            for (int jj = 0; jj < 8; ++jj) { const f32x4 w = *(const LAS f32x4*)(wf + jj * 1024 + 4 * (lane + 64 * j));
                dj[jj] += (v[j][0] * w[0] + v[j][1] * w[1]) + (v[j][2] * w[2] + v[j][3] * w[3]); } }
        const float rstd = 1.0f / sqrtf(wave_sum(s) * (1.0f / DM) + 1e-6f);
        float r4[4], r2[2], r1;
#pragma unroll
        for (int i = 0; i < 4; ++i) { const float keep = (lane & 1) ? dj[4 + i] : dj[i], send = (lane & 1) ? dj[i] : dj[4 + i]; r4[i] = keep + __shfl_xor(send, 1); }
#pragma unroll
        for (int i = 0; i < 2; ++i) { const float keep = (lane & 2) ? r4[2 + i] : r4[i], send = (lane & 2) ? r4[i] : r4[2 + i]; r2[i] = keep + __shfl_xor(send, 2); }
        { const float keep = (lane & 4) ? r2[1] : r2[0], send = (lane & 4) ? r2[0] : r2[1]; r1 = keep + __shfl_xor(send, 4); }
        r1 += __shfl_xor(r1, 8); r1 += __shfl_xor(r1, 16); r1 += __shfl_xor(r1, 32);
        const int jo = 4 * (lane & 1) + 2 * ((lane >> 1) & 1) + ((lane >> 2) & 1);
        v2u* o8 = (v2u*)(xb + (size_t)mrow * DM) + lane;
#pragma unroll
        for (int j = 0; j < 4; ++j) { v2u w; w.x = pk2(v[j][0], v[j][1]); w.y = pk2(v[j][2], v[j][3]); o8[64 * j] = w; }
        if (lane == 0) rs0[mrow] = rstd;
        if (lane < 8) { const float z = r1 * rstd + P.in[13][jo]; const float ls = fminf(z, 0.f) - log1pf(expf(-fabsf(z)));
            const int b = mrow >> 12, sidx = mrow & 4095; lf[(size_t)(b * 8 + jo) * SEQ + sidx] = ls; }
    }
    if (wave == 0 && blockIdx.x == 8 % gridDim.x) {
        const float a = wave_sum(P.in[6][lane] * P.in[7][lane]), b = wave_sum(P.in[8][lane] * P.in[9][lane]);
        float ga = fabsf(P.in[4][lane] * P.in[5][lane]), gb = fabsf(P.in[11][lane] * P.in[12][lane]), gc = fabsf(P.in[17][lane] * P.in[18][lane]);
#pragma unroll
        for (int o = 1; o < 64; o <<= 1) { ga = fmaxf(ga, __shfl_xor(ga, o)); gb = fmaxf(gb, __shfl_xor(gb, o)); gc = fmaxf(gc, __shfl_xor(gc, o)); }
        if (lane == 0) { float* ctl = (float*)(ws + WS_CTL); ctl[0] = expf(a) - expf(b) + 0.2f;
            ctl[1] = 8.0f * ga * LOG2E * 1.02f + 0.25f; ctl[2] = 8.0f * gb * LOG2E * 1.02f + 0.25f; ctl[3] = 8.0f * gc * LOG2E * 1.02f + 0.25f; }
    }
    if (wave == 0) {
        for (int hh = blockIdx.x; hh < 8; hh += gridDim.x) {
            float gd = fabsf(P.in[20][lane] * P.in[21][lane]), t = -INFINITY;
            for (int i = lane; i < 320; i += 64) t = fmaxf(t, P.in[22][hh * 320 + i]);
#pragma unroll
            for (int o = 1; o < 64; o <<= 1) { gd = fmaxf(gd, __shfl_xor(gd, o)); t = fmaxf(t, __shfl_xor(t, o)); }
            if (lane == 0) ((float*)(ws + WS_CTL))[8 + hh] = 8.0f * gd * LOG2E * 1.02f + 0.25f + t * LOG2E;
        }
    }
}
constexpr int LATE_W_ITEMS = (16 * (DM / 32) + 16 * (N1 / 32) + 16 * (DM / 32)) / 8;
__device__ __forceinline__ void late_weight_item(const Params& P, LAS unsigned char* lds, int bitem, int lane, int wave) {
    constexpr int IO = 16 * (DM / 32), I1 = 16 * (N1 / 32);
    LAS float* scr = (LAS float*)(lds + wave * 8704);
    int r = bitem * 8 + wave;
    if (r < IO) p0_transpose_item(P.in[3], DM, DM, nullptr, false, -1, -1, (bf16*)(P.ws + WS_BTO0), scr, r, lane);
    else if (r < IO + I1) p0_transpose_item(P.in[15], N1, N1, P.in[14], true, 4, 12, (bf16*)(P.ws + WS_BT1), scr, r - IO, lane);
    else p0_transpose_item(P.in[16], DM, DM, nullptr, false, -1, -1, (bf16*)(P.ws + WS_BTO1), scr, r - IO - I1, lane);
    __syncthreads();
}
#define XB_TMO      128
#define XB_XCNT(j)  (256  + 64 * (j))
#define XB_XSUB(j)  (1280 + 64 * (j))
#define XB_XGEN(j)  (2304 + 64 * (j))
#define XB_TOP      3328
#define XB_TOPGEN   3392
#define XCD_BAR_WORDS 3456
#define XB_SPIN_CAP (1u << 18)

__device__ __forceinline__ unsigned xb_ld(unsigned* p)              { return __hip_atomic_load(p, __ATOMIC_RELAXED, __HIP_MEMORY_SCOPE_AGENT); }
__device__ __forceinline__ unsigned xb_add(unsigned* p, unsigned v) { return __hip_atomic_fetch_add(p, v, __ATOMIC_RELAXED, __HIP_MEMORY_SCOPE_AGENT); }
__device__ __forceinline__ unsigned xb_xcc_id() { return (unsigned)__builtin_amdgcn_s_getreg((3 << 11) | 20) & 0xFu; }
#define XB_SPIN(cond, bar) do { unsigned _sp = 0; while (cond) { __builtin_amdgcn_s_sleep(1); \
    if ((++_sp & 255u) == 0u) { if (xb_ld(&(bar)[XB_TMO])) break; if (_sp > XB_SPIN_CAP) { atomicAdd(&(bar)[XB_TMO], 1u); break; } } } } while (0)

struct XcdBarrier {
    unsigned* bar; unsigned x;
    volatile LAS unsigned* st;
};

__device__ __forceinline__ XcdBarrier xcd_barrier_post(unsigned* bar, volatile LAS unsigned* st) {
    XcdBarrier b; b.bar = bar; b.x = xb_xcc_id(); b.st = st;
    if (threadIdx.x == 0) (void)xb_add(&bar[XB_XCNT(b.x)], 1u);
    return b;
}
__device__ __forceinline__ void xcd_barrier_complete(unsigned* bar, unsigned x, unsigned& nloc, unsigned& nx) {
    const unsigned G = gridDim.x * gridDim.y * gridDim.z;
    unsigned sum, cnt, mine, sp = 0u;
    for (;;) {
        sum = 0u; cnt = 0u; mine = 0u;
#pragma unroll
        for (unsigned j = 0; j < 16; ++j) { const unsigned c = xb_ld(&bar[XB_XCNT(j)]); sum += c; cnt += (c > 0u) ? 1u : 0u; mine = (j == x) ? c : mine; }
        if (sum == G) break;
        __builtin_amdgcn_s_sleep(1);
        if ((++sp & 255u) == 0u) { if (xb_ld(&bar[XB_TMO])) break; if (sp > XB_SPIN_CAP) { atomicAdd(&bar[XB_TMO], 1u); break; } }
    }
    nloc = mine > 0u ? mine : 1u; nx = cnt > 0u ? cnt : 1u;
}

__device__ __forceinline__ void xcd_barrier(const XcdBarrier& b) {
    asm volatile("s_waitcnt vmcnt(0)" ::: "memory");
    __syncthreads();
    if (threadIdx.x == 0) {
        unsigned* bar = b.bar;
        __builtin_amdgcn_s_waitcnt(0);
        unsigned nloc = b.st[0], nx = b.st[1];
        if (nloc == 0u) { xcd_barrier_complete(bar, b.x, nloc, nx); b.st[0] = nloc; b.st[1] = nx; }
        const unsigned old = xb_add(&bar[XB_XSUB(b.x)], 1u);
        const unsigned gen = old / nloc;
        if (old + 1u == (gen + 1u) * nloc) {
            __builtin_amdgcn_fence(__ATOMIC_RELEASE, "agent");
            asm volatile("s_waitcnt vmcnt(0)" ::: "memory");
            const unsigned og = xb_add(&bar[XB_TOP], 1u);
            const unsigned tg = og / nx;
            if (og + 1u == (tg + 1u) * nx) xb_add(&bar[XB_TOPGEN], 1u);
            else XB_SPIN(xb_ld(&bar[XB_TOPGEN]) == tg, bar);
            __builtin_amdgcn_fence(__ATOMIC_ACQUIRE, "agent");
            xb_add(&bar[XB_XGEN(b.x)], 1u);
            asm volatile("s_waitcnt vmcnt(0)" ::: "memory");
        } else {
            XB_SPIN(xb_ld(&bar[XB_XGEN(b.x)]) == gen, bar);
            __builtin_amdgcn_fence(__ATOMIC_ACQUIRE, "agent");
            asm volatile("s_waitcnt vmcnt(0)" ::: "memory");
        }
    }
    __syncthreads();
}

__device__ __forceinline__ void unit_A(const Params& P, LAS unsigned char* lds, int bh, int qa, int tid, int lane, int wave) {
    const int b = bh >> 2, h = bh & 3, r32 = lane & 31, hi = lane >> 5;
    const bf16* Zb = (const bf16*)(P.ws + WS_Z) + (size_t)b * SEQ * N0;
    const int c = wave >> 2, j = wave & 3, q0w = 128 * qa + 32 * j, chunk = 2 * qa + (j >> 1);
    const float slope = exp2f(-2.0f * (float)(h + 1));
    const float thr = 150.0f / (slope * LOG2E);
    const int t_lo = max(0, (int)ceilf(((float)(128 * qa) - thr - 63.0f) * (1.0f / 64.0f))), w_lo = max(0, (int)ceilf(((float)q0w - thr - 63.0f) * (1.0f / 64.0f)));
    f32x16 o[4]; float l; att::u32x4 gdum[4];
    att::attn_core<2, 2, 0>(lds, Zb, N0, h * 128 + c * 64, 512 + h * 128, 512 + h * 128 + 64, 1024 + h * 128, q0w, t_lo, 2 * qa + 1, w_lo, chunk, c, -slope * LOG2E, -1, o, ((const float*)(P.ws + WS_CTL))[1], l, -1, gdum);
    const float inv = 1.0f / l;
    LAS f32x4* xs = (LAS f32x4*)lds + j * 1024 + lane;
    if (c == 1) {
#pragma unroll
        for (int i = 0; i < 4; ++i)
#pragma unroll
            for (int r4 = 0; r4 < 4; ++r4) xs[(i * 4 + r4) * 64] = (f32x4){o[i][4 * r4] * inv, o[i][4 * r4 + 1] * inv, o[i][4 * r4 + 2] * inv, o[i][4 * r4 + 3] * inv};
    }
    __syncthreads();
    if (c == 0) {
        const float lam = ((const float*)(P.ws + WS_CTL))[0];
        float ss = 0.f;
#pragma unroll
        for (int i = 0; i < 4; ++i)
#pragma unroll
            for (int r4 = 0; r4 < 4; ++r4) { const f32x4 x1 = xs[(i * 4 + r4) * 64];
#pragma unroll
                for (int e = 0; e < 4; ++e) { const float v = o[i][4 * r4 + e] * inv - lam * x1[e]; o[i][4 * r4 + e] = v; ss += v * v; } }
        ss += __shfl_xor(ss, 32);
        const float rn = 0.8f / sqrtf(ss * (1.0f / 128.0f) + 1e-6f);
        const size_t row = (size_t)b * SEQ + q0w + r32;
        const bf16* grow = (const bf16*)(P.ws + WS_Z) + row * N0 + 1536 + h * 128;
        bf16* orow = (bf16*)(P.ws + WS_MIX) + row * DM + h * 128;
        const float* sg = P.in[10];
#pragma unroll
        for (int i = 0; i < 4; ++i)
#pragma unroll
            for (int jp = 0; jp < 2; ++jp) {
                const int cb = 32 * i + 16 * jp + 8 * hi;
                const v4u L = *(const v4u*)(grow + cb);
                const auto g0 = __builtin_amdgcn_permlane32_swap(L.x, L.z, false, false), g1 = __builtin_amdgcn_permlane32_swap(L.y, L.w, false, false);
                v2u w[2];
#pragma unroll
                for (int q = 0; q < 2; ++q) { const int jj = 2 * jp + q, d = 32 * i + 8 * jj + 4 * hi; const unsigned gx = q ? g0[1] : g0[0], gy = q ? g1[1] : g1[0];
                    const f32x4 s4 = *(const f32x4*)(sg + d);
                    const float a0 = __uint_as_float(gx << 16), a1 = __uint_as_float(gx & 0xffff0000u), a2 = __uint_as_float(gy << 16), a3 = __uint_as_float(gy & 0xffff0000u);
                    w[q].x = att::cvtpk(o[i][4 * jj] * rn * s4[0] * a0, o[i][4 * jj + 1] * rn * s4[1] * a1); w[q].y = att::cvtpk(o[i][4 * jj + 2] * rn * s4[2] * a2, o[i][4 * jj + 3] * rn * s4[3] * a3); }
                const auto s0 = __builtin_amdgcn_permlane32_swap(w[0].x, w[1].x, false, false), s1 = __builtin_amdgcn_permlane32_swap(w[0].y, w[1].y, false, false);
                *(v4u*)(orow + cb) = (v4u){s0[0], s1[0], s0[1], s1[1]};
            }
    }
    __syncthreads();
}
__device__ __forceinline__ void unit_B(const Params& P, LAS unsigned char* lds, int bh, int qb, int tid, int lane, int wave) {
    const int b = bh >> 3, h = bh & 7, r32 = lane & 31, hi = lane >> 5;
    const bf16* Zb = (const bf16*)(P.ws + WS_Z) + (size_t)b * SEQ * N0;
    const int q0w = 256 * qb + 32 * wave, chunk = 4 * qb + (wave >> 1);
    {
        const float* lfs = (const float*)(P.ws + WS_LF) + (size_t)bh * SEQ;
        LAS float* cl = (LAS float*)(lds + att::LDS_CUM);
        LAS float* part = (LAS float*)(lds + MISC_OFF + 256);
        const int n = 256 * (qb + 1); const bool mine = tid * 8 < n;
        f32x4 a4 = (f32x4){0.f, 0.f, 0.f, 0.f}, b4 = a4;
        if (mine) { const f32x4* src = (const f32x4*)(lfs + tid * 8); a4 = src[0]; b4 = src[1]; }
        float v0 = a4[0], v1 = v0 + a4[1], v2 = v1 + a4[2], v3 = v2 + a4[3], v4 = v3 + b4[0], v5 = v4 + b4[1], v6 = v5 + b4[2], v7 = v6 + b4[3];
        float inc = v7;
#pragma unroll
        for (int o_ = 1; o_ < 64; o_ <<= 1) { const float t_ = __shfl_up(inc, o_); if (lane >= o_) inc += t_; }
        if (lane == 63) part[wave] = inc;
        __syncthreads();
        float base = inc - v7;
#pragma unroll
        for (int w_ = 0; w_ < 8; ++w_) if (w_ < wave) base += part[w_];
        if (tid == 32 * qb) part[8] = v0 + base;
        __syncthreads();
        const float cref = part[8];
        if (mine) { LAS f32x4* dst = (LAS f32x4*)(cl + tid * 8);
            dst[0] = (f32x4){(cref - (v0 + base)) * LOG2E, (cref - (v1 + base)) * LOG2E, (cref - (v2 + base)) * LOG2E, (cref - (v3 + base)) * LOG2E};
            dst[1] = (f32x4){(cref - (v4 + base)) * LOG2E, (cref - (v5 + base)) * LOG2E, (cref - (v6 + base)) * LOG2E, (cref - (v7 + base)) * LOG2E}; }
    }
    __syncthreads();
    const float mrow = ((const float*)(P.ws + WS_CTL))[2] + ((const LAS float*)(lds + att::LDS_CUM))[q0w + r32];
    int t_lo, w_lo;
    { const LAS float* cl = (const LAS float*)(lds + att::LDS_CUM); const int ti = lane <= 4 * qb + 3 ? lane : 4 * qb + 3; const float ce = cl[64 * ti + 63];
      const unsigned long long kw = __ballot(ce - cl[q0w] >= -150.0f), kb = __ballot(ce - cl[256 * qb] >= -150.0f);
      w_lo = kw ? (int)__builtin_ctzll(kw) : chunk; t_lo = kb ? (int)__builtin_ctzll(kb) : 4 * qb; if (w_lo > chunk) w_lo = chunk; }
    t_lo = __builtin_amdgcn_readfirstlane(t_lo); w_lo = __builtin_amdgcn_readfirstlane(w_lo);
    f32x16 o[2]; float l; att::u32x4 gpre[4];
    att::attn_core<1, 1, 1>(lds, Zb, N0, 2048 + h * 64, 2560 + h * 64, 0, 3072 + h * 64, q0w, t_lo, 4 * qb + 3, w_lo, chunk, 0, 0.f, chunk, o, mrow, l, 3584 + h * 64, gpre);
    const size_t row = (size_t)b * SEQ + q0w + r32;
    att::store_gated(o, 1.0f / l, gpre, (bf16*)(P.ws + WS_MIX) + row * DM + 512 + h * 64, hi);
}
__device__ __forceinline__ void unit_C(const Params& P, LAS unsigned char* lds, int b, int kvh, int c, int tid, int lane, int wave) {
    const int r32 = lane & 31, hi = lane >> 5, h = kvh * 4 + (wave >> 1);
    const bf16* Zb = (const bf16*)(P.ws + WS_Z) + (size_t)b * SEQ * N1;
    const int q0w = 64 * c + 32 * (wave & 1);
    const int t_lo = (c - 2) > 0 ? c - 2 : 0;
    const float slope = exp2f(-(float)(h + 1));
    const float m = ((const float*)(P.ws + WS_CTL))[3];
    f32x16 o[2]; float l; att::u32x4 gpre[4];
    att::attn_core<1, 1, 2>(lds, Zb, N1, h * 64, 512 + kvh * 64, 0, 640 + kvh * 64, q0w, t_lo, c, t_lo, c, 0, -slope * LOG2E, -1, o, m, l, 768 + h * 64, gpre);
    l += exp2f(P.in[19][h] * LOG2E - m);
    const size_t row = (size_t)b * SEQ + q0w + r32;
    att::store_gated(o, 1.0f / l, gpre, (bf16*)(P.ws + WS_MIX) + row * DM + h * 64, hi);
}
__device__ __forceinline__ void unit_D(const Params& P, LAS unsigned char* lds, int bh, int qb, int tid, int lane, int wave) {
    const int b = bh >> 3, h = bh & 7, r32 = lane & 31, hi = lane >> 5;
    const bf16* Zb = (const bf16*)(P.ws + WS_Z) + (size_t)b * SEQ * N1;
    const int q0w = 256 * qb + 32 * wave, chunk = 4 * qb + (wave >> 1);
    const int t_lo = (4 * qb - 8) > 0 ? 4 * qb - 8 : 0, w_lo = (chunk - 8) > 0 ? chunk - 8 : 0;
    { LAS float* tb = (LAS float*)(lds + att::LDS_TAB); const float* rt = P.in[22] + h * 320;
      const float mh = ((const float*)(P.ws + WS_CTL))[8 + h];
      for (int i = tid; i < 640; i += NTHR) { const int e = 638 - i; tb[i] = rt[e < 319 ? (e < 0 ? 0 : e) : 319] * LOG2E - mh; } }
    const float m = ((const float*)(P.ws + WS_CTL))[8 + h];
    f32x16 o[2]; float l; att::u32x4 gpre[4];
    att::attn_core<1, 1, 3>(lds, Zb, N1, 1280 + h * 64, 1792 + h * 64, 0, 2304 + h * 64, q0w, t_lo, 4 * qb + 3, w_lo, chunk, 0, 0.f, -1, o, m, l, 2816 + h * 64, gpre);
    const size_t row = (size_t)b * SEQ + q0w + r32;
    att::store_gated(o, 1.0f / l, gpre, (bf16*)(P.ws + WS_MIX) + row * DM + 512 + h * 64, hi);
}
__device__ __forceinline__ int queue_next(unsigned* ctr, LAS unsigned char* lds, int tid) {
    volatile LAS int* w = (volatile LAS int*)(lds + MISC_OFF);
    if (tid == 0) w[0] = (int)atomicAdd(ctr, 1u);
    __syncthreads();
    const int it = w[0];
    __syncthreads();
    return it;
}

__global__ void __launch_bounds__(NTHR, 2) trunk_fwd(Params P) {
    extern __shared__ __attribute__((aligned(16))) unsigned char lds_raw[];
    LAS unsigned char* lds = (LAS unsigned char*)lds_raw;
    const int tid = threadIdx.x, lane = tid & 63, wave = __builtin_amdgcn_readfirstlane(tid >> 6);
    const int lo = P.ph_lo, hi_ = P.ph_hi, G = gridDim.x;
    unsigned char* ws = P.ws;
#define IN(k) (lo <= (k) && (k) < hi_)
    { volatile LAS unsigned* mz = (volatile LAS unsigned*)(lds + MISC_OFF); if (tid < 64) mz[tid] = 0u; }
    __syncthreads();
    XcdBarrier bar = xcd_barrier_post((unsigned*)(ws + WS_CTL) + CW_BAR, (volatile LAS unsigned*)(lds + MISC_OFF + 64));
    if (P.ph_hi > 1000) cg::this_grid().sync();
#define SEAM(k) do { if (IN(k) && IN((k) + 1)) { xcd_barrier(bar); } } while (0)
    if (IN(0)) { p0_prologue(P, lds, tid, lane, wave); __syncthreads();
#if PROBE_REP0
        p0_prologue(P, lds, tid, lane, wave); __syncthreads();
#endif
    }
    SEAM(0);
    if (IN(1)) {
        pg8::Gemm g{(const bf16*)(ws + WS_XB), (const bf16*)(ws + WS_BT0), M, N0, DM}; pg8::StaticOrder S; S.init(M, N0, G, (int)blockIdx.x);
        pg8::EpiIn E{(bf16*)(ws + WS_Z), N0, (const float*)(ws + WS_RS0), nullptr,
                     {8, 16, 24, 32, 40, 48, 56, 64}, {1, 2, 0, 3, 1, 2, 0, 3}, {P.in[4], P.in[5], nullptr, nullptr, P.in[11], P.in[12], nullptr, nullptr}, 0, -1, -1};
        pg8::gemm_phase<pg8::EpiIn, pg8::StaticOrder, PG8_ALIGN, PG8_SP2>(lds, g, S, E);
        __syncthreads();
#if PROBE_REP1
        pg8::gemm_phase<pg8::EpiIn, pg8::StaticOrder, PG8_ALIGN, PG8_SP2>(lds, g, S, E);
        __syncthreads();
#endif
    }
    SEAM(1);
    if (IN(2)) {
        unsigned* ctr = (unsigned*)(ws + WS_CTL) + 64;
        int it = (int)blockIdx.x;
        for (;;) {
            if (it >= 1024) break;
            const int pp = it >> 6, r = it & 63;
            if (r < 16) unit_A(P, lds, r, 31 - 2 * pp, tid, lane, wave);
            else if (r < 48) unit_B(P, lds, r - 16, 15 - pp, tid, lane, wave);
            else unit_A(P, lds, r - 48, 30 - 2 * pp, tid, lane, wave);
            it = G + queue_next(ctr, lds, tid);
        }
        while (it < 1024 + LATE_W_ITEMS) { late_weight_item(P, lds, it - 1024, lane, wave); it = G + queue_next(ctr, lds, tid); }
    }
    SEAM(2);
    if (IN(3)) {
        pg8::Gemm g{(const bf16*)(ws + WS_MIX), (const bf16*)(ws + WS_BTO0), M, DM, DM}; pg8::StaticOrder S; S.init(M, DM, G, (int)blockIdx.x);
        pg8::EpiOut E{P.in[0], nullptr, nullptr, (bf16*)(ws + WS_XB), (float*)(ws + WS_SSQ)};
        pg8::gemm_phase<pg8::EpiOut, pg8::StaticOrder, false, PG8_SP2>(lds, g, S, E);
        __syncthreads();
#if PROBE_REP3
        pg8::gemm_phase<pg8::EpiOut, pg8::StaticOrder, false, PG8_SP2>(lds, g, S, E);
        __syncthreads();
#endif
    }
    SEAM(3);
    if (IN(4)) {
        pg8::Gemm g{(const bf16*)(ws + WS_XB), (const bf16*)(ws + WS_BT1), M, 3072, DM}; pg8::StaticOrder S; S.init(M, 3072, G, (int)blockIdx.x);
        pg8::EpiIn E{(bf16*)(ws + WS_Z), N1, nullptr, (const float*)(ws + WS_SSQ),
                     {8, 10, 12, 20, 28, 36, 44, 52}, {1, 2, 0, 3, 1, 2, 0, 3}, {P.in[17], P.in[18], nullptr, nullptr, P.in[20], P.in[21], nullptr, nullptr}, 0, 4, 12};
        pg8::gemm_phase<pg8::EpiIn, pg8::StaticOrder, PG8_ALIGN, PG8_SP2>(lds, g, S, E);
        __syncthreads();
    }
    SEAM(4);
    if (IN(5)) {
        unsigned* late = (unsigned*)(ws + WS_CTL) + 320;
        {
            pg8::Gemm g2{(const bf16*)(ws + WS_XB), (const bf16*)(ws + WS_BT1) + (size_t)3072 * 1024, M, 256, DM}; pg8::StaticOrder S2; S2.init(M, 256, G, (int)blockIdx.x);
            pg8::Unit u0; int n_mine = 0; while (S2.next(n_mine, u0)) ++n_mine;
            const bool mine = n_mine > 0;
            pg8::EpiIn E2{(bf16*)(ws + WS_Z), N1, nullptr, (const float*)(ws + WS_SSQ),
                          {8, 10, 12, 20, 28, 36, 44, 52}, {1, 2, 0, 3, 1, 2, 0, 3}, {P.in[17], P.in[18], nullptr, nullptr, P.in[20], P.in[21], nullptr, nullptr}, 12, 4, 12};
            pg8::gemm_phase<pg8::EpiIn, pg8::StaticOrder, PG8_ALIGN, PG8_SP2>(lds, g2, S2, E2);
            if (mine) {
                asm volatile("s_waitcnt vmcnt(0)" ::: "memory"); __syncthreads();
                if (tid == 0) { __builtin_amdgcn_fence(__ATOMIC_RELEASE, "agent"); asm volatile("s_waitcnt vmcnt(0)" ::: "memory"); (void)xb_add(late, (unsigned)n_mine); }
                __syncthreads();
            }
        }
        bool late_ok = false;
        for (int rep = 0; rep < 1 + PROBE_REP5; ++rep) {
        unsigned* ctr = (unsigned*)(ws + WS_CTL) + 128 + 128 * rep;
        for (int it = (int)blockIdx.x; it < 1024; it = G + queue_next(ctr, lds, tid)) {
            if (it < 512) { const int bh = it & 31, qb = 15 - (it >> 5); unit_D(P, lds, bh, qb, tid, lane, wave); }
            else {
                const int r = it - 512, half = r >> 8, idx = r & 255, cc = 63 - (idx >> 2), bb = idx & 3;
                if (half && !late_ok) {
                    if (tid == 0) { unsigned sp = 0; while (xb_ld(late) < 64u) { __builtin_amdgcn_s_sleep(2); if (++sp > (1u << 22)) break; }
                        __builtin_amdgcn_fence(__ATOMIC_ACQUIRE, "agent"); asm volatile("s_waitcnt vmcnt(0)" ::: "memory"); }
                    __syncthreads(); late_ok = true;
                }
                unit_C(P, lds, bb, half, cc, tid, lane, wave);
            }
        }
        }
    }
    SEAM(5);
    if (IN(6)) {
        pg8::Gemm g{(const bf16*)(ws + WS_MIX), (const bf16*)(ws + WS_BTO1), M, DM, DM}; pg8::StaticOrder S; S.init(M, DM, G, (int)blockIdx.x);
        pg8::EpiOut E{nullptr, (const bf16*)(ws + WS_XB), P.out, nullptr, nullptr};
        pg8::gemm_phase<pg8::EpiOut, pg8::StaticOrder, false, PG8_SP2>(lds, g, S, E);
    }
#undef IN
#undef SEAM
}

extern "C" void kernel_launch(void* const* d_in, const int* in_sizes, int n_in, void* d_out, int out_size, void* d_ws, size_t ws_size, hipStream_t stream) {
    static int grid = 0;
    if (grid == 0) {
        if (n_in != 23 || out_size != M * DM || ws_size < WS_END) { fprintf(stderr, "kernel_launch: unexpected shapes (n_in %d, out %d, ws %zu)\n", n_in, out_size, ws_size); grid = -1; return; }
        int dev = 0, cus = 0, per_cu = 0;
        hipGetDevice(&dev); hipDeviceGetAttribute(&cus, hipDeviceAttributeMultiprocessorCount, dev);
        if (hipFuncSetAttribute((const void*)trunk_fwd, hipFuncAttributeMaxDynamicSharedMemorySize, LDS_BYTES) != hipSuccess) { fprintf(stderr, "kernel_launch: hipFuncSetAttribute failed\n"); grid = -1; return; }
        if (hipOccupancyMaxActiveBlocksPerMultiprocessor(&per_cu, (const void*)trunk_fwd, NTHR, LDS_BYTES) != hipSuccess || per_cu < 1) { fprintf(stderr, "kernel_launch: occupancy query says %d\n", per_cu); per_cu = 1; }
        (void)hipGetLastError();
        grid = cus * 1;
        if (grid <= 0) grid = 256;
    }
    if (grid < 0) return;
    if (hipMemsetAsync((char*)d_ws + WS_CTL, 0, 65536, stream) != hipSuccess) { fprintf(stderr, "kernel_launch: memset failed\n"); return; }
    Params p{};
    for (int i = 0; i < 23; ++i) p.in[i] = (const float*)d_in[i];
    p.out = (float*)d_out; p.ws = (unsigned char*)d_ws;
#if MK_LAUNCHES == 1
    p.ph_lo = 0; p.ph_hi = 7;
    void* args[] = {&p};
    hipError_t e = hipLaunchCooperativeKernel((const void*)trunk_fwd, dim3(grid), dim3(NTHR), args, LDS_BYTES, stream);
    if (e != hipSuccess) fprintf(stderr, "kernel_launch: cooperative launch failed: %s (grid %d)\n", hipGetErrorString(e), grid);
#else
    for (int ph = 0; ph < 7; ++ph) { p.ph_lo = ph; p.ph_hi = ph + 1; hipLaunchKernelGGL(trunk_fwd, dim3(grid), dim3(NTHR), LDS_BYTES, stream, p); }
#endif
}
```

```cpp
#include <hip/hip_runtime.h>
#include <hip/hip_cooperative_groups.h>
#include <cstdio>
#include <cstdint>
namespace cg = cooperative_groups;
#ifndef PROBE_REP0
#define PROBE_REP0 0
#endif
#ifndef PROBE_REP3
#define PROBE_REP3 0
#endif
#ifndef PROBE_REP4
#define PROBE_REP4 0
#endif
#ifndef PROBE_REP1
#define PROBE_REP1 0
#endif
#ifndef PROBE_REP2
#define PROBE_REP2 0
#endif
#ifndef PROBE_REP5
#define PROBE_REP5 0
#endif
#ifndef MK_LAUNCHES
#define MK_LAUNCHES 1
#endif
namespace pg8 {
#define PG8_LAS __attribute__((address_space(3)))
typedef unsigned short bf16_t;
typedef short bf16x8 __attribute__((ext_vector_type(8)));
typedef float f32x4 __attribute__((ext_vector_type(4)));
typedef unsigned u32x4 __attribute__((ext_vector_type(4)));
constexpr int BM = 256, BK = 64, HALF = 128, HTB = HALF * BK * 2  , STAGE_BYTES = 8 * HTB, NXCD = 8, WGM = 8;

__host__ __device__ __forceinline__ int lds_byte(int r, int c) { const int st = (r >> 4) * 2 + (c >> 5), rr = r & 15, cc = c & 31, ob = rr * 64 + cc * 2; return st * 1024 + (ob ^ (((ob >> 9) & 1) << 5)); }
__host__ __device__ __forceinline__ void stage_rc(int b, int& R, int& C) { const int st = b / 1024, sb = b % 1024, swz = sb ^ (((sb >> 9) & 1) << 5); R = (st >> 1) * 16 + swz / 64; C = (st & 1) * 32 + (swz % 64) / 2; }
__host__ __device__ __forceinline__ int perm32(int rho) { const int n = rho >> 4, i = rho & 15; return 8 * (i >> 2) + 4 * n + (i & 3); }

struct Unit { int pm, pn; };
struct Gemm { const bf16_t* A; const bf16_t* Bt; int M, N, K; };

struct StaticOrder {
    int nM, nN, nwg, G, c;
    __host__ __device__ void init(int M, int N, int G_, int c_) { nM = M / BM; nN = N / BM; nwg = nM * nN; G = G_; c = c_; }
    __host__ __device__ bool next(int i, Unit& u) const {
        const long L = (long)i * G + c; if (L >= nwg) return false;
        int wgid = (int)L; { const int q = nwg / NXCD, r = nwg % NXCD, xcd = wgid % NXCD, off = wgid / NXCD; wgid = (xcd < r ? xcd * (q + 1) : r * (q + 1) + (xcd - r) * q) + off; }
        const int nig = WGM * nN, gid = wgid / nig, fm = gid * WGM, gsz = (nM - fm) < WGM ? (nM - fm) : WGM;
        u.pm = fm + ((wgid % nig) % gsz); u.pn = (wgid % nig) / gsz; return true;
    }
    __device__ __forceinline__ void a_ready(const Unit&) const {}
    __device__ __forceinline__ void done(const Unit&) const {}
};

__device__ __forceinline__ unsigned cvt_pk_bf16(float lo, float hi) { unsigned r; asm volatile("v_cvt_pk_bf16_f32 %0, %1, %2" : "=v"(r) : "v"(lo), "v"(hi)); return r; }
typedef float f32x2 __attribute__((ext_vector_type(2)));
typedef unsigned u32x2 __attribute__((ext_vector_type(2)));
constexpr float QK_C2 = 0.125f * 1.4426950408889634f;
struct EpiIn {
    static constexpr bool PERM = true, AFTER_DRAIN = false;
    bf16_t* O; int ldc; const float* rs; const float* ssq;
    int seg_end[8]; int seg_mode[8]; const float* seg_g[8];
    int pn_off, sw_a, sw_b;
    __device__ __forceinline__ void operator()(const f32x4 (&acc)[2][2][4][2], const Unit& u, int wr, int wc, int fr, int fq) const {
        int lt = u.pn + pn_off; lt = (lt == sw_a) ? sw_b : (lt == sw_b ? sw_a : lt);
        const int gidx = lt * 4 + wc;
        int mode = 0; const float* g = nullptr;
#pragma unroll
        for (int s = 7; s >= 0; --s) if (gidx < seg_end[s]) { mode = seg_mode[s]; g = seg_g[s]; }
        f32x4 gv[2][2];
#pragma unroll
        for (int bj = 0; bj < 2; ++bj)
#pragma unroll
            for (int n = 0; n < 2; ++n) gv[bj][n] = (mode == 1 || mode == 2) ? *(const f32x4*)(g + 32 * bj + 8 * fq + 4 * n) : (f32x4){1.f, 1.f, 1.f, 1.f};
        const float qs = (mode == 1) ? QK_C2 : 1.0f;
        float rr[2][4];
        if (rs) {
#pragma unroll
            for (int ai = 0; ai < 2; ++ai)
#pragma unroll
                for (int m = 0; m < 4; ++m) rr[ai][m] = rs[u.pm * BM + ai * HALF + wr * 64 + m * 16 + fr];
        }
        asm volatile("" ::: "memory");
#pragma unroll
        for (int ai = 0; ai < 2; ++ai) {
            if (!rs) {
                f32x4 sp[4][4];
#pragma unroll
                for (int m = 0; m < 4; ++m) { const f32x4* p_ = (const f32x4*)(ssq + (size_t)(u.pm * BM + ai * HALF + wr * 64 + m * 16 + fr) * 16);
#pragma unroll
                    for (int q = 0; q < 4; ++q) sp[m][q] = p_[q]; }
                asm volatile("" ::: "memory");
#pragma unroll
                for (int m = 0; m < 4; ++m) { const f32x4 a = sp[m][0], b = sp[m][1], c = sp[m][2], d = sp[m][3];
                    const float t = ((a[0] + a[1]) + (a[2] + a[3])) + ((b[0] + b[1]) + (b[2] + b[3])) + ((c[0] + c[1]) + (c[2] + c[3])) + ((d[0] + d[1]) + (d[2] + d[3]));
                    rr[ai][m] = __builtin_amdgcn_rsqf(t * (1.0f / 1024.0f) + 1e-6f); }
            }
#pragma unroll
            for (int m = 0; m < 4; ++m) {
                const int row = u.pm * BM + ai * HALF + wr * 64 + m * 16 + fr;
                const float r = rr[ai][m];
                f32x4 v[2][2];
#pragma unroll
                for (int bj = 0; bj < 2; ++bj)
#pragma unroll
                    for (int n = 0; n < 2; ++n) v[bj][n] = acc[ai][bj][m][n] * r;
                if (mode == 1 || mode == 2) {
                    float ss = 0.f;
#pragma unroll
                    for (int bj = 0; bj < 2; ++bj)
#pragma unroll
                        for (int n = 0; n < 2; ++n) { const f32x4 x = v[bj][n]; ss += (x[0] * x[0] + x[1] * x[1]) + (x[2] * x[2] + x[3] * x[3]); }
                    ss += __shfl_xor(ss, 16); ss += __shfl_xor(ss, 32);
                    const float rn = qs * __builtin_amdgcn_rsqf(ss * (1.0f / 64.0f) + 1e-6f);
#pragma unroll
                    for (int bj = 0; bj < 2; ++bj)
#pragma unroll
                        for (int n = 0; n < 2; ++n) v[bj][n] = v[bj][n] * rn * gv[bj][n];
                } else if (mode == 3) {
#pragma unroll
                    for (int bj = 0; bj < 2; ++bj)
#pragma unroll
                        for (int n = 0; n < 2; ++n)
#pragma unroll
                            for (int e = 0; e < 4; ++e) { const float x = v[bj][n][e]; v[bj][n][e] = x * __builtin_amdgcn_rcpf(1.0f + __builtin_amdgcn_exp2f(x * -1.4426950408889634f)); }
                }
                bf16_t* rowp = O + (size_t)row * ldc + lt * BM + wc * 64 + 8 * fq;
#pragma unroll
                for (int bj = 0; bj < 2; ++bj) { u32x4 w; w.x = cvt_pk_bf16(v[bj][0][0], v[bj][0][1]); w.y = cvt_pk_bf16(v[bj][0][2], v[bj][0][3]); w.z = cvt_pk_bf16(v[bj][1][0], v[bj][1][1]); w.w = cvt_pk_bf16(v[bj][1][2], v[bj][1][3]);
                    *(u32x4*)(rowp + bj * 32) = w; }
            }
        }
    }
};
struct EpiOut {
    static constexpr bool PERM = true, AFTER_DRAIN = false;
    const float* base; const bf16_t* base16; float* out; bf16_t* xb; float* ssq;
    __device__ __forceinline__ void operator()(const f32x4 (&acc)[2][2][4][2], const Unit& u, int wr, int wc, int fr, int fq) const {
        const int col0 = u.pn * BM + wc * 32 + 8 * fq;
#pragma unroll
        for (int ai = 0; ai < 2; ++ai) {
            f32x4 pre[4][2][2];
#pragma unroll
            for (int m = 0; m < 4; ++m) { const size_t off = (size_t)(u.pm * BM + ai * HALF + wr * 64 + m * 16 + fr) * 1024 + col0;
#pragma unroll
                for (int bj = 0; bj < 2; ++bj) {
                    if (base16) { const u32x4 w = *(const u32x4*)(base16 + off + bj * HALF);
                        pre[m][bj][0] = (f32x4){__uint_as_float(w.x << 16), __uint_as_float(w.x & 0xffff0000u), __uint_as_float(w.y << 16), __uint_as_float(w.y & 0xffff0000u)};
                        pre[m][bj][1] = (f32x4){__uint_as_float(w.z << 16), __uint_as_float(w.z & 0xffff0000u), __uint_as_float(w.w << 16), __uint_as_float(w.w & 0xffff0000u)}; }
                    else { pre[m][bj][0] = *(const f32x4*)(base + off + bj * HALF); pre[m][bj][1] = *(const f32x4*)(base + off + bj * HALF + 4); } } }
            asm volatile("" ::: "memory");
#pragma unroll
            for (int m = 0; m < 4; ++m) {
                const int row = u.pm * BM + ai * HALF + wr * 64 + m * 16 + fr;
                const size_t off = (size_t)row * 1024 + col0;
                float ss = 0.f;
#pragma unroll
                for (int bj = 0; bj < 2; ++bj) {
                    const f32x4 o0 = pre[m][bj][0] + acc[ai][bj][m][0], o1 = pre[m][bj][1] + acc[ai][bj][m][1];
                    if (out) { *(f32x4*)(out + off + bj * HALF) = o0; *(f32x4*)(out + off + bj * HALF + 4) = o1; }
                    ss += (o0[0] * o0[0] + o0[1] * o0[1]) + (o0[2] * o0[2] + o0[3] * o0[3]) + (o1[0] * o1[0] + o1[1] * o1[1]) + (o1[2] * o1[2] + o1[3] * o1[3]);
                    if (xb) { u32x4 w; w.x = cvt_pk_bf16(o0[0], o0[1]); w.y = cvt_pk_bf16(o0[2], o0[3]); w.z = cvt_pk_bf16(o1[0], o1[1]); w.w = cvt_pk_bf16(o1[2], o1[3]);
                        *(u32x4*)(xb + off + bj * HALF) = w; }
                }
                if (ssq) { ss += __shfl_xor(ss, 16); ss += __shfl_xor(ss, 32); if (fq == 0) ssq[(size_t)row * 16 + u.pn * 4 + wc] = ss; }
            }
            asm volatile("" ::: "memory");
        }
    }
};

template <class Epi, class Sched, bool ALIGN_EPI = false, bool SP2 = false>
__device__ __forceinline__ void gemm_phase(PG8_LAS unsigned char* lds, const Gemm g, const Sched& S, const Epi& E) {
    const int tid = threadIdx.x, wid = __builtin_amdgcn_readfirstlane(tid >> 6), lane = tid & 63, wr = wid >> 2, wc = wid & 3, fr = lane & 15, fq = lane >> 4;
    const int K = g.K, nt = K / BK;
    unsigned voffA[2], voffB[2];
#pragma unroll
    for (int i = 0; i < 2; ++i) { int R, C; stage_rc(tid * 16 + i * 8192, R, C); const int Rb = Epi::PERM ? ((R & ~31) + perm32(R & 31)) : R;
        voffA[i] = (unsigned)(R * K + C) * 2u; voffB[i] = (unsigned)(Rb * K + C) * 2u; }
    const size_t kstep = (size_t)(BK * 2);
    const size_t hstep = (size_t)HALF * K * 2;
    const size_t tstep = 2 * hstep;
    const unsigned ldsw = (unsigned)wid * 1024u;
    const int aoff = lds_byte(wr * 64 + fr, fq * 8), boff = lds_byte(wc * 32 + fr, fq * 8);
#define PG8_SA(b, h) (((b) * 2 + (h)) * HTB)
#define PG8_SB(b, h) ((4 + (b) * 2 + (h)) * HTB)
#define PG8_STAGE(bufoff, gbase, voff) do { _Pragma("unroll") for (int _i = 0; _i < 2; ++_i) \
        __builtin_amdgcn_global_load_lds((const unsigned*)((const char*)(gbase) + (voff)[_i]), (PG8_LAS unsigned*)(lds + (bufoff) + ldsw + _i * 8192), 16, 0, 0); } while (0)
#define PG8_LDA(dst, b, h) do { _Pragma("unroll") for (int m = 0; m < 4; ++m) _Pragma("unroll") for (int k = 0; k < 2; ++k) dst[m][k] = *(const PG8_LAS bf16x8*)(lds + PG8_SA(b, h) + aoff + m * 2048 + k * 1024); } while (0)
#define PG8_LDB(dst, b, h) do { _Pragma("unroll") for (int n = 0; n < 2; ++n) _Pragma("unroll") for (int k = 0; k < 2; ++k) dst[n][k] = *(const PG8_LAS bf16x8*)(lds + PG8_SB(b, h) + boff + n * 2048 + k * 1024); } while (0)
#define PG8_MMA(ai, bj, At, Bt) do { __builtin_amdgcn_s_setprio(1); _Pragma("unroll") for (int m = 0; m < 4; ++m) _Pragma("unroll") for (int n = 0; n < 2; ++n) _Pragma("unroll") for (int k = 0; k < 2; ++k) \
        acc[ai][bj][m][n] = __builtin_amdgcn_mfma_f32_16x16x32_bf16(Bt[n][k], At[m][k], acc[ai][bj][m][n], 0, 0, 0); __builtin_amdgcn_s_setprio(0); } while (0)
#define PG8_WAIT_V(n) asm volatile("s_waitcnt vmcnt(" #n ")" ::: "memory")
#define PG8_WAIT_L(n) asm volatile("s_waitcnt lgkmcnt(" #n ")" ::: "memory")
#define PG8_BAR __builtin_amdgcn_s_barrier()
#define PG8_SCHED __builtin_amdgcn_sched_barrier(0)
    Unit cur, nxt; int ui = 0;
    if (!S.next(0, cur)) return;
    f32x4 acc[2][2][4][2];
#pragma unroll
    for (int a = 0; a < 2; ++a)
#pragma unroll
        for (int b = 0; b < 2; ++b)
#pragma unroll
            for (int m = 0; m < 4; ++m)
#pragma unroll
                for (int n = 0; n < 2; ++n) acc[a][b][m][n] = (f32x4){0.f, 0.f, 0.f, 0.f};
    bf16x8 At[4][2], B0[2][2], B1[2][2];
    const char* cA = (const char*)g.A + (size_t)cur.pm * tstep; const char* cB = (const char*)g.Bt + (size_t)cur.pn * tstep;
    S.a_ready(cur);
    if constexpr (SP2) {
        PG8_STAGE(PG8_SB(0, 0), cB, voffB); PG8_STAGE(PG8_SB(0, 1), cB + hstep, voffB); PG8_STAGE(PG8_SA(0, 0), cA, voffA); PG8_STAGE(PG8_SA(0, 1), cA + hstep, voffA);
        if (wr == 1) PG8_BAR;
        PG8_WAIT_V(2); PG8_BAR;
        PG8_STAGE(PG8_SB(1, 0), cB + kstep, voffB); PG8_STAGE(PG8_SA(1, 0), cA + kstep, voffA); PG8_STAGE(PG8_SB(1, 1), cB + hstep + kstep, voffB);
        PG8_WAIT_V(6); PG8_BAR;
    } else {
        PG8_STAGE(PG8_SB(0, 0), cB, voffB); PG8_STAGE(PG8_SA(0, 0), cA, voffA); PG8_STAGE(PG8_SB(0, 1), cB + hstep, voffB); PG8_STAGE(PG8_SA(0, 1), cA + hstep, voffA);
        if (wr == 1) PG8_BAR;
        PG8_WAIT_V(4); PG8_BAR;
        PG8_STAGE(PG8_SB(1, 0), cB + kstep, voffB); PG8_STAGE(PG8_SA(1, 0), cA + kstep, voffA); PG8_STAGE(PG8_SB(1, 1), cB + hstep + kstep, voffB);
        PG8_WAIT_V(6); PG8_BAR;
    }
    for (;;) {
        const bool has_next = S.next(ui + 1, nxt);
        const char* nA = has_next ? (const char*)g.A + (size_t)nxt.pm * tstep : cA; const char* nB = has_next ? (const char*)g.Bt + (size_t)nxt.pn * tstep : cB;
        for (int t = 0; t < nt; t += 2) {
            const bool last = (t == nt - 2);
            const char* a1 = cA + (size_t)(t + 1) * kstep;
            const char* a2 = last ? nA : cA + (size_t)(t + 2) * kstep; const char* b2 = last ? nB : cB + (size_t)(t + 2) * kstep;
            const char* a3 = a2 + kstep; const char* b3 = b2 + kstep;
            if (last && has_next) S.a_ready(nxt);
            if constexpr (SP2) {
            PG8_LDB(B0, 0, 0); PG8_LDB(B1, 0, 1); PG8_SCHED; PG8_LDA(At, 0, 0); PG8_STAGE(PG8_SA(1, 1), a1 + hstep, voffA);
            PG8_WAIT_V(8); PG8_WAIT_L(0); PG8_BAR; PG8_MMA(0, 0, At, B0); PG8_MMA(0, 1, At, B1); PG8_BAR; PG8_SCHED;
            PG8_LDA(At, 0, 1); PG8_STAGE(PG8_SB(0, 0), b2, voffB); PG8_STAGE(PG8_SB(0, 1), b2 + hstep, voffB); PG8_STAGE(PG8_SA(0, 0), a2, voffA);
            PG8_WAIT_V(8); PG8_WAIT_L(0); PG8_BAR; PG8_MMA(1, 0, At, B0); PG8_MMA(1, 1, At, B1); PG8_BAR; PG8_SCHED;
            PG8_LDB(B0, 1, 0); PG8_LDB(B1, 1, 1); PG8_SCHED; PG8_LDA(At, 1, 0); PG8_STAGE(PG8_SA(0, 1), a2 + hstep, voffA);
            PG8_WAIT_V(8); PG8_WAIT_L(0); PG8_BAR; PG8_MMA(0, 0, At, B0); PG8_MMA(0, 1, At, B1); PG8_BAR; PG8_SCHED;
            PG8_LDA(At, 1, 1); PG8_STAGE(PG8_SB(1, 0), b3, voffB); PG8_STAGE(PG8_SB(1, 1), b3 + hstep, voffB); PG8_STAGE(PG8_SA(1, 0), a3, voffA);
            PG8_WAIT_V(8); PG8_WAIT_L(0); PG8_BAR; PG8_MMA(1, 0, At, B0); PG8_MMA(1, 1, At, B1); PG8_BAR; PG8_SCHED;
            } else {
            PG8_LDB(B0, 0, 0); PG8_SCHED; PG8_LDA(At, 0, 0); PG8_STAGE(PG8_SA(1, 1), a1 + hstep, voffA);
            PG8_WAIT_L(8); PG8_BAR; PG8_WAIT_L(0); PG8_MMA(0, 0, At, B0); PG8_BAR; PG8_SCHED;
            PG8_LDB(B1, 0, 1); PG8_STAGE(PG8_SB(0, 0), b2, voffB);
            PG8_BAR; PG8_WAIT_L(0); PG8_MMA(0, 1, At, B1); PG8_BAR;
            PG8_LDA(At, 0, 1); PG8_STAGE(PG8_SA(0, 0), a2, voffA);
            PG8_BAR; PG8_WAIT_L(0); PG8_MMA(1, 0, At, B0); PG8_BAR; PG8_SCHED;
            PG8_STAGE(PG8_SB(0, 1), b2 + hstep, voffB);
            PG8_WAIT_V(6); PG8_BAR; PG8_MMA(1, 1, At, B1); PG8_BAR;
            PG8_LDB(B0, 1, 0); PG8_SCHED; PG8_LDA(At, 1, 0); PG8_STAGE(PG8_SA(0, 1), a2 + hstep, voffA);
            PG8_WAIT_L(8); PG8_BAR; PG8_WAIT_L(0); PG8_MMA(0, 0, At, B0); PG8_BAR; PG8_SCHED;
            PG8_LDB(B1, 1, 1); PG8_STAGE(PG8_SB(1, 0), b3, voffB);
            PG8_BAR; PG8_WAIT_L(0); PG8_MMA(0, 1, At, B1); PG8_BAR;
            PG8_LDA(At, 1, 1); PG8_STAGE(PG8_SA(1, 0), a3, voffA);
            PG8_BAR; PG8_WAIT_L(0); PG8_MMA(1, 0, At, B0); PG8_BAR; PG8_SCHED;
            PG8_STAGE(PG8_SB(1, 1), b3 + hstep, voffB);
            PG8_WAIT_V(6); PG8_BAR; PG8_MMA(1, 1, At, B1); PG8_BAR;
            }
        }
        if constexpr (ALIGN_EPI) { if (wr == 0) PG8_BAR; }
        if constexpr (!Epi::AFTER_DRAIN) { E(acc, cur, wr, wc, fr, fq); S.done(cur); }
        if (!has_next) break;
#pragma unroll
        for (int a = 0; a < 2; ++a)
#pragma unroll
            for (int b = 0; b < 2; ++b)
#pragma unroll
                for (int m = 0; m < 4; ++m)
#pragma unroll
                    for (int n = 0; n < 2; ++n) acc[a][b][m][n] = (f32x4){0.f, 0.f, 0.f, 0.f};
        cur = nxt; cA = nA; cB = nB; ++ui;
        if constexpr (ALIGN_EPI) { if (wr == 1) PG8_BAR; }
    }
    PG8_WAIT_V(0);
    if constexpr (!ALIGN_EPI) { if (wr == 0) PG8_BAR; }
    PG8_BAR;
    if constexpr (Epi::AFTER_DRAIN) { E.fused(acc, cur, wr, wc, fr, fq, lds, wid, lane); S.done(cur); }
#undef PG8_SA
#undef PG8_SB
#undef PG8_STAGE
#undef PG8_LDA
#undef PG8_LDB
#undef PG8_MMA
#undef PG8_WAIT_V
#undef PG8_WAIT_L
#undef PG8_BAR
#undef PG8_SCHED
}
}
#define PG8_SP2 true
#define PG8_ALIGN true
namespace att {
typedef unsigned short bf16_t;
typedef __attribute__((address_space(3))) unsigned char* lptr;
typedef __attribute__((address_space(3))) const unsigned char* lcptr;
typedef short bf16x8 __attribute__((ext_vector_type(8)));
typedef short s16x4 __attribute__((ext_vector_type(4)));
typedef float f32x16 __attribute__((ext_vector_type(16)));
typedef float f32x4 __attribute__((ext_vector_type(4)));
typedef unsigned u32x4 __attribute__((ext_vector_type(4)));
typedef unsigned u32x2 __attribute__((ext_vector_type(2)));
typedef float f32x2_t __attribute__((ext_vector_type(2)));
typedef __bf16 bf16x2_t __attribute__((ext_vector_type(2)));
constexpr float LOG2E = 1.4426950408889634f;
constexpr int SLOT = 32768, LDS_CUM = 65536, LDS_TAB = 81920;
__device__ __forceinline__ unsigned cvtpk(float lo, float hi) { f32x2_t v = {lo, hi}; bf16x2_t b = __builtin_convertvector(v, bf16x2_t); return __builtin_bit_cast(unsigned, b); }
__device__ __forceinline__ float bf2f(unsigned short h) { return __uint_as_float(((unsigned)h) << 16); }
__device__ __forceinline__ void glds16(const void* gsrc, unsigned lds_dst) { unsigned keep;
    asm volatile("s_mov_b32 %0, m0\n\ts_mov_b32 m0, %2\n\ts_nop 0\n\tglobal_load_lds_dwordx4 %1, off\n\ts_mov_b32 m0, %0" : "=&s"(keep) : "v"(gsrc), "s"(lds_dst) : "memory"); }
__device__ __forceinline__ float fadd_s(float a, float b) { return a + b; }
__device__ __forceinline__ float fsub_s(float a, float b) { return a - b; }
__device__ __forceinline__ s16x4 vtr(lcptr p) { return __builtin_bit_cast(s16x4, __builtin_amdgcn_ds_read_tr16_b64_v4i16((__attribute__((address_space(3))) s16x4*)p)); }

template <int VD, int NK, int MODE>
__device__ __forceinline__ void attn_core(lptr lds, const bf16_t* Zb, int ldz, int qcol, int kcol0, int kcol1, int vcol, int q0w,
                                          int t_lo, int t_hi, int w_lo, int w_hi, int ksel, float nsl, int diag_t,
                                          f32x16 (&o)[2 * VD], float mref, float& l_run, int gcol, u32x4 (&gpre)[4]) {
    const int tid = threadIdx.x, lane = tid & 63, r32 = lane & 31, hi = lane >> 5;
    const int wv_ = __builtin_amdgcn_readfirstlane(tid >> 6);
    const int krow_ = 8 * wv_ + (lane >> 3), kchk_ = (lane & 7) ^ ((krow_ >> 1) & 7);
    const bf16_t* ksrc0 = Zb + (size_t)krow_ * ldz + kcol0 + kchk_ * 8;
    const bf16_t* ksrc1 = Zb + (size_t)krow_ * ldz + kcol1 + kchk_ * 8;
    const bf16_t* vsrc = Zb + (size_t)krow_ * ldz + vcol + ((lane & 7) ^ (4 * ((lane >> 4) & 1))) * 8;
    const unsigned lds0 = (unsigned)(uintptr_t)lds + (unsigned)wv_ * 1024u;
#define ATT_DMA(t, sl) do { const size_t go_ = (size_t)(t) * 64 * ldz; const unsigned d_ = (unsigned)__builtin_amdgcn_readfirstlane(lds0 + (unsigned)(sl) * SLOT); \
        glds16(ksrc0 + go_, d_); if (NK == 2) glds16(ksrc1 + go_, d_ + 8192u); glds16(vsrc + go_, d_ + 16384u); if (VD == 2) glds16(vsrc + go_ + 64, d_ + 24576u); } while (0)
#define ATT_DMA_WAIT() asm volatile("s_waitcnt vmcnt(0)" ::: "memory")
    bf16x8 qr[4];
    { const bf16_t* qp = Zb + (size_t)(q0w + r32) * ldz + qcol + hi * 8;
#pragma unroll
      for (int d0 = 0; d0 < 4; ++d0) qr[d0] = *(const bf16x8*)(qp + d0 * 16); }
#pragma unroll
    for (int i = 0; i < 2 * VD; ++i) o[i] = f32x16{};
    const float m = mref; float l = 0.f;
    const int qabs = q0w + r32;
    unsigned koff[4];
#pragma unroll
    for (int d0 = 0; d0 < 4; ++d0) koff[d0] = (unsigned)(ksel * 8192 + r32 * 128 + (((2 * d0 + hi) ^ ((r32 >> 1) & 7)) << 4));
    unsigned vfr[2];
#pragma unroll
    for (int dh = 0; dh < 2; ++dh) vfr[dh] = (unsigned)(16384 + (4 * hi + ((lane & 15) >> 2)) * 128 + ((dh ^ ((lane >> 3) & 1)) * 64) + ((lane >> 4) & 1) * 32 + (lane & 3) * 8);
    if (gcol >= 0) {
        const bf16_t* gp = Zb + (size_t)(q0w + r32) * ldz + gcol + 8 * hi;
#pragma unroll
        for (int i = 0; i < 4; ++i) gpre[i] = *(const u32x4*)(gp + 32 * (i >> 1) + 16 * (i & 1));
    }
    ATT_DMA(t_lo, 0); ATT_DMA_WAIT();
    if (gcol >= 0) asm volatile("" : "+v"(gpre[0]), "+v"(gpre[1]), "+v"(gpre[2]), "+v"(gpre[3]));
    __syncthreads();
    const float nnsl = -nsl;
    for (int t = t_lo; t <= t_hi; ++t) {
        const int cur = (t - t_lo) & 1;
        const bool act_ = (t >= w_lo && t <= w_hi);
        if (!act_) { if (t < t_hi) ATT_DMA(t + 1, cur ^ 1); }
        if (act_) {
            lcptr sb = (lcptr)(lds + cur * SLOT);
            bf16x8 kf[8];
#pragma unroll
            for (int d0 = 0; d0 < 4; ++d0) { kf[2 * d0] = *(const __attribute__((address_space(3))) bf16x8*)(sb + koff[d0]); kf[2 * d0 + 1] = *(const __attribute__((address_space(3))) bf16x8*)(sb + koff[d0] + 4096); }
            s16x4 vlo[8], vhh[8];
#pragma unroll
            for (int i = 0; i < 8; ++i) { vlo[i] = vtr(sb + vfr[i >> 2] + (i & 3) * 2048); vhh[i] = vtr(sb + vfr[i >> 2] + (i & 3) * 2048 + 1024); }
            __builtin_amdgcn_sched_barrier(0);
            f32x16 p0, p1;
            if (MODE == 0 || MODE == 2) {
                const float fq = (float)(qabs - 64 * t - 4 * hi);
                if (t == w_hi) {
#pragma unroll
                    for (int r = 0; r < 16; ++r) { const float c = (float)((r & 3) + 8 * (r >> 2));
                        p0[r] = __builtin_fmaf(nsl, __builtin_fabsf(fq - c), -m); p1[r] = __builtin_fmaf(nsl, __builtin_fabsf(fq - c - 32.0f), -m); }
                } else {
                    const float sh = __builtin_fmaf(nsl, fq, -m), n8 = 8.0f * nnsl, n32 = 32.0f * nnsl;
                    float bj_ = sh;
#pragma unroll
                    for (int j = 0; j < 4; ++j) { p0[4 * j] = bj_; p0[4 * j + 1] = fadd_s(p0[4 * j], nnsl); p0[4 * j + 2] = fadd_s(p0[4 * j + 1], nnsl); p0[4 * j + 3] = fadd_s(p0[4 * j + 2], nnsl);
                        if (j < 3) bj_ = fadd_s(bj_, n8); }
#pragma unroll
                    for (int r = 0; r < 16; ++r) p1[r] = fadd_s(p0[r], n32);
                }
            } else if (MODE == 1) {
                const __attribute__((address_space(3))) float* cl = (const __attribute__((address_space(3))) float*)(lds + LDS_CUM) + 64 * t + 4 * hi;
#pragma unroll
                for (int j = 0; j < 4; ++j) { const f32x4 c0 = *(const __attribute__((address_space(3))) f32x4*)(cl + 8 * j), c1 = *(const __attribute__((address_space(3))) f32x4*)(cl + 8 * j + 32);
#pragma unroll
                    for (int e = 0; e < 4; ++e) { p0[4 * j + e] = fsub_s(c0[e], m); p1[4 * j + e] = fsub_s(c1[e], m); } }
            } else {
                const __attribute__((address_space(3))) float* tb = (const __attribute__((address_space(3))) float*)(lds + LDS_TAB) + (575 - (qabs - 64 * t - 4 * hi));
#pragma unroll
                for (int r = 0; r < 16; ++r) { const int c = (r & 3) + 8 * (r >> 2); p0[r] = tb[c]; p1[r] = tb[c + 32]; }
            }
#pragma unroll
            for (int d0 = 0; d0 < 4; ++d0) {
                p0 = __builtin_amdgcn_mfma_f32_32x32x16_bf16(kf[2 * d0], qr[d0], p0, 0, 0, 0);
                p1 = __builtin_amdgcn_mfma_f32_32x32x16_bf16(kf[2 * d0 + 1], qr[d0], p1, 0, 0, 0);
            }
            if (t < t_hi) ATT_DMA(t + 1, cur ^ 1);

            if (MODE == 1) { if (t == diag_t) { const int qrel = (qabs & 63) - 4 * hi;
#pragma unroll
                    for (int r = 0; r < 16; ++r) { const int kv = (r & 3) + 8 * (r >> 2); if (kv > qrel) p0[r] = -INFINITY; if (kv + 32 > qrel) p1[r] = -INFINITY; } } }
            float sa = 0.f, sb_ = 0.f;
#pragma unroll
            for (int r = 0; r < 16; ++r) { p0[r] = __builtin_amdgcn_exp2f(p0[r]); p1[r] = __builtin_amdgcn_exp2f(p1[r]); sa = fadd_s(sa, p0[r]); sb_ = fadd_s(sb_, p1[r]); }
            l += sa + sb_;
            u32x4 pw[4];
            pw[0] = (u32x4){cvtpk(p0[0], p0[1]), cvtpk(p0[2], p0[3]), cvtpk(p0[4], p0[5]), cvtpk(p0[6], p0[7])};
            pw[1] = (u32x4){cvtpk(p0[8], p0[9]), cvtpk(p0[10], p0[11]), cvtpk(p0[12], p0[13]), cvtpk(p0[14], p0[15])};
            pw[2] = (u32x4){cvtpk(p1[0], p1[1]), cvtpk(p1[2], p1[3]), cvtpk(p1[4], p1[5]), cvtpk(p1[6], p1[7])};
            pw[3] = (u32x4){cvtpk(p1[8], p1[9]), cvtpk(p1[10], p1[11]), cvtpk(p1[12], p1[13]), cvtpk(p1[14], p1[15])};
#pragma unroll
            for (int i = 0; i < 8; ++i) { const bf16x8 vf = (bf16x8){vlo[i][0], vlo[i][1], vlo[i][2], vlo[i][3], vhh[i][0], vhh[i][1], vhh[i][2], vhh[i][3]};
                o[i >> 2] = __builtin_amdgcn_mfma_f32_32x32x16_bf16(vf, __builtin_bit_cast(bf16x8, pw[i & 3]), o[i >> 2], 0, 0, 0); }
            if (VD == 2) {
#pragma unroll
                for (int i = 0; i < 8; ++i) { const s16x4 lo = vtr(sb + vfr[i >> 2] + 8192 + (i & 3) * 2048), hh = vtr(sb + vfr[i >> 2] + 8192 + (i & 3) * 2048 + 1024);
                    const bf16x8 vf = (bf16x8){lo[0], lo[1], lo[2], lo[3], hh[0], hh[1], hh[2], hh[3]};
                    o[2 + (i >> 2)] = __builtin_amdgcn_mfma_f32_32x32x16_bf16(vf, __builtin_bit_cast(bf16x8, pw[i & 3]), o[2 + (i >> 2)], 0, 0, 0); }
            }
        }
        ATT_DMA_WAIT();
        __syncthreads();
    }
    { auto rr = __builtin_amdgcn_permlane32_swap(__float_as_uint(l), __float_as_uint(l), false, false); l = __uint_as_float(rr[0]) + __uint_as_float(rr[1]); }
    l_run = l;
#undef ATT_DMA
#undef ATT_DMA_WAIT
}
__device__ __forceinline__ void store_gated(const f32x16 (&o)[2], float inv, const u32x4 (&gpre)[4], bf16_t* orow, int hi) {
#pragma unroll
    for (int dh = 0; dh < 2; ++dh)
#pragma unroll
        for (int jp = 0; jp < 2; ++jp) {
            const int cb = 32 * dh + 16 * jp + 8 * hi;
            const u32x4 L = gpre[dh * 2 + jp];
            const auto g0 = __builtin_amdgcn_permlane32_swap(L.x, L.z, false, false), g1 = __builtin_amdgcn_permlane32_swap(L.y, L.w, false, false);
            u32x2 w[2];
#pragma unroll
            for (int q = 0; q < 2; ++q) { const int j = 2 * jp + q; const unsigned gx = q ? g0[1] : g0[0], gy = q ? g1[1] : g1[0];
                const float a0 = __uint_as_float(gx << 16), a1 = __uint_as_float(gx & 0xffff0000u), a2 = __uint_as_float(gy << 16), a3 = __uint_as_float(gy & 0xffff0000u);
                w[q].x = cvtpk(o[dh][4 * j] * inv * a0, o[dh][4 * j + 1] * inv * a1); w[q].y = cvtpk(o[dh][4 * j + 2] * inv * a2, o[dh][4 * j + 3] * inv * a3); }
            const auto s0 = __builtin_amdgcn_permlane32_swap(w[0].x, w[1].x, false, false), s1 = __builtin_amdgcn_permlane32_swap(w[0].y, w[1].y, false, false);
            *(u32x4*)(orow + cb) = (u32x4){s0[0], s1[0], s0[1], s1[1]};
        }
}
}
typedef unsigned short bf16;
typedef float f32x4 __attribute__((ext_vector_type(4)));
typedef float f32x16 __attribute__((ext_vector_type(16)));
typedef unsigned v4u __attribute__((ext_vector_type(4)));
typedef unsigned v2u __attribute__((ext_vector_type(2)));
#define LAS __attribute__((address_space(3)))
constexpr int NWAVES = 8, NTHR = 512;
constexpr int M = 16384, DM = 1024, SEQ = 4096;
constexpr int N0 = 4096, LDW0 = 4104, N1 = 3328;
constexpr size_t MiB = 1u << 20;
constexpr size_t WS_CTL = 0, WS_BT0 = 2 * MiB, WS_BTO0 = 10 * MiB, WS_BT1 = 12 * MiB, WS_BTO1 = 19 * MiB, WS_RS0 = 21 * MiB, WS_LF = 22 * MiB, WS_SSQ = 24 * MiB,
                 WS_XB = 32 * MiB, WS_Z = 64 * MiB, WS_MIX = 192 * MiB, WS_END = 224 * MiB;
constexpr int RING_BYTES = 131072, MISC_OFF = RING_BYTES, LDS_BYTES = RING_BYTES + 4096;
constexpr float LOG2E = 1.4426950408889634f;
constexpr int CW_BAR = 4096;

__device__ __forceinline__ unsigned f2bf(float f) { unsigned u = __builtin_bit_cast(unsigned, f); return (u + 0x7fffu + ((u >> 16) & 1u)) >> 16; }
__device__ __forceinline__ unsigned pk2(float lo, float hi) { return f2bf(lo) | (f2bf(hi) << 16); }
__device__ __forceinline__ float wave_sum(float v) {
#pragma unroll
    for (int o = 1; o < 64; o <<= 1) v += __shfl_xor(v, o);
    return v;
}
__device__ __forceinline__ void p0_transpose_item(const float* W, int ldw, int N, const float* gain, bool permute, int swa, int swb, bf16* WT, LAS float* scr, int item, int lane) {
    const int nblk = N / 32, kb = item / nblk, nb = item % nblk, k0 = 64 * kb, n0 = 32 * nb;
    float wv[32];
#pragma unroll
    for (int i = 0; i < 32; ++i) { const int kk = 2 * i + (lane >> 5); wv[i] = __builtin_nontemporal_load(W + (size_t)(k0 + kk) * ldw + n0 + (lane & 31)); }
    const float gl = gain ? gain[k0 + lane] : 1.0f;
#pragma unroll
    for (int i = 0; i < 32; ++i) { const int kk = 2 * i + (lane >> 5); scr[kk * 33 + (lane & 31)] = wv[i] * __shfl(gl, kk); }
    asm volatile("s_waitcnt lgkmcnt(0)" ::: "memory");
    const int c = lane & 7;
#pragma unroll
    for (int j = 0; j < 4; ++j) { const int n = (lane >> 3) + 8 * j; const LAS float* s = scr + (8 * c) * 33 + n;
        v4u o; o.x = pk2(s[0 * 33], s[1 * 33]); o.y = pk2(s[2 * 33], s[3 * 33]); o.z = pk2(s[4 * 33], s[5 * 33]); o.w = pk2(s[6 * 33], s[7 * 33]);
        int nl = n0 + n;
        if (permute) { int tile = nl >> 8; tile = (tile == swa) ? swb : (tile == swb ? swa : tile);
            const int t = nl & 255; nl = (tile << 8) | (((t >> 5) & 1) << 7) | (((t >> 6) & 3) << 5) | (t & 31); }
        *(v4u*)(WT + (size_t)nl * 1024 + k0 + 8 * c) = o; }
    asm volatile("s_waitcnt lgkmcnt(0)" ::: "memory");
}

struct Params { const float* in[23]; float* out; unsigned char* ws; int ph_lo, ph_hi; };

__device__ __forceinline__ void p0_prologue(const Params& P, LAS unsigned char* lds, int tid, int lane, int wave) {
    const int G = gridDim.x, gw = blockIdx.x * NWAVES + wave, NGW = G * NWAVES;
    unsigned char* ws = P.ws;
    LAS float* wf = (LAS float*)(lds + 98304);
    { float t0[16], t1[16];
#pragma unroll
      for (int u = 0; u < 16; ++u) { const int i = tid + NTHR * u, k = i >> 3, j = i & 7; t0[u] = P.in[1][k]; t1[u] = P.in[2][(size_t)k * LDW0 + N0 + j]; }
#pragma unroll
      for (int u = 0; u < 16; ++u) { const int i = tid + NTHR * u, k = i >> 3, j = i & 7; wf[j * 1024 + k] = t0[u] * t1[u]; } }
    LAS float* scr = (LAS float*)(lds + wave * 8704);
    constexpr int I0 = 16 * (N0 / 32);
    for (int it = gw; it < I0; it += NGW) p0_transpose_item(P.in[2], LDW0, N0, P.in[1], true, -1, -1, (bf16*)(ws + WS_BT0), scr, it, lane);
    __syncthreads();
    const float* x = P.in[0]; bf16* xb = (bf16*)(ws + WS_XB); float* rs0 = (float*)(ws + WS_RS0); float* lf = (float*)(ws + WS_LF);
    f32x4 vn[4];
    if (gw < M) { const f32x4* xr = (const f32x4*)(x + (size_t)gw * DM) + lane;
#pragma unroll
        for (int j = 0; j < 4; ++j) vn[j] = __builtin_nontemporal_load(xr + 64 * j); }
    for (int mrow = gw; mrow < M; mrow += NGW) {
        f32x4 v[4];
#pragma unroll
        for (int j = 0; j < 4; ++j) v[j] = vn[j];
        if (mrow + NGW < M) { const f32x4* xr = (const f32x4*)(x + (size_t)(mrow + NGW) * DM) + lane;
#pragma unroll
            for (int j = 0; j < 4; ++j) vn[j] = __builtin_nontemporal_load(xr + 64 * j); }
        float s = 0.f; float dj[8];
#pragma unroll
        for (int j = 0; j < 8; ++j) dj[j] = 0.f;
#pragma unroll
        for (int j = 0; j < 4; ++j) { s += (v[j][0] * v[j][0] + v[j][1] * v[j][1]) + (v[j][2] * v[j][2] + v[j][3] * v[j][3]);
#pragma unroll
            for (int jj = 0; jj < 8; ++jj) { const f32x4 w = *(const LAS f32x4*)(wf + jj * 1024 + 4 * (lane + 64 * j));
                dj[jj] += (v[j][0] * w[0] + v[j][1] * w[1]) + (v[j][2] * w[2] + v[j][3] * w[3]); } }
        const float rstd = 1.0f / sqrtf(wave_sum(s) * (1.0f / DM) + 1e-6f);
        float r4[4], r2[2], r1;
#pragma unroll
        for (int i = 0; i < 4; ++i) { const float keep = (lane & 1) ? dj[4 + i] : dj[i], send = (lane & 1) ? dj[i] : dj[4 + i]; r4[i] = keep + __shfl_xor(send, 1); }
#pragma unroll
        for (int i = 0; i < 2; ++i) { const float keep = (lane & 2) ? r4[2 + i] : r4[i], send = (lane & 2) ? r4[i] : r4[2 + i]; r2[i] = keep + __shfl_xor(send, 2); }
        { const float keep = (lane & 4) ? r2[1] : r2[0], send = (lane & 4) ? r2[0] : r2[1]; r1 = keep + __shfl_xor(send, 4); }
        r1 += __shfl_xor(r1, 8); r1 += __shfl_xor(r1, 16); r1 += __shfl_xor(r1, 32);
        const int jo = 4 * (lane & 1) + 2 * ((lane >> 1) & 1) + ((lane >> 2) & 1);
        v2u* o8 = (v2u*)(xb + (size_t)mrow * DM) + lane;
#pragma unroll
        for (int j = 0; j < 4; ++j) { v2u w; w.x = pk2(v[j][0], v[j][1]); w.y = pk2(v[j][2], v[j][3]); o8[64 * j] = w; }
        if (lane == 0) rs0[mrow] = rstd;
        if (lane < 8) { const float z = r1 * rstd + P.in[13][jo]; const float ls = fminf(z, 0.f) - log1pf(expf(-fabsf(z)));
            const int b = mrow >> 12, sidx = mrow & 4095; lf[(size_t)(b * 8 + jo) * SEQ + sidx] = ls; }
    }
    if (wave == 0 && blockIdx.x == 8 % gridDim.x) {
        const float a = wave_sum(P.in[6][lane] * P.in[7][lane]), b = wave_sum(P.in[8][lane] * P.in[9][lane]);
        float ga = fabsf(P.in[4][lane] * P.in[5][lane]), gb = fabsf(P.in[11][lane] * P.in[12][lane]), gc = fabsf(P.in[17][lane] * P.in[18][lane]);
#pragma unroll
        for (int o = 1; o < 64; o <<= 1) { ga = fmaxf(ga, __shfl_xor(ga, o)); gb = fmaxf(gb, __shfl_xor(gb, o)); gc = fmaxf(gc, __shfl_xor(gc, o)); }
        if (lane == 0) { float* ctl = (float*)(ws + WS_CTL); ctl[0] = expf(a) - expf(b) + 0.2f;
            ctl[1] = 8.0f * ga * LOG2E * 1.02f + 0.25f; ctl[2] = 8.0f * gb * LOG2E * 1.02f + 0.25f; ctl[3] = 8.0f * gc * LOG2E * 1.02f + 0.25f; }
    }
    if (wave == 0) {
        for (int hh = blockIdx.x; hh < 8; hh += gridDim.x) {
            float gd = fabsf(P.in[20][lane] * P.in[21][lane]), t = -INFINITY;
            for (int i = lane; i < 320; i += 64) t = fmaxf(t, P.in[22][hh * 320 + i]);
#pragma unroll
            for (int o = 1; o < 64; o <<= 1) { gd = fmaxf(gd, __shfl_xor(gd, o)); t = fmaxf(t, __shfl_xor(t, o)); }
            if (lane == 0) ((float*)(ws + WS_CTL))[8 + hh] = 8.0f * gd * LOG2E * 1.02f + 0.25f + t * LOG2E;
        }
    }
}
constexpr int LATE_W_ITEMS = (16 * (DM / 32) + 16 * (N1 / 32) + 16 * (DM / 32)) / 8;
__device__ __forceinline__ void late_weight_item(const Params& P, LAS unsigned char* lds, int bitem, int lane, int wave) {
    constexpr int IO = 16 * (DM / 32), I1 = 16 * (N1 / 32);
    LAS float* scr = (LAS float*)(lds + wave * 8704);
    int r = bitem * 8 + wave;
    if (r < IO) p0_transpose_item(P.in[3], DM, DM, nullptr, false, -1, -1, (bf16*)(P.ws + WS_BTO0), scr, r, lane);
    else if (r < IO + I1) p0_transpose_item(P.in[15], N1, N1, P.in[14], true, 4, 12, (bf16*)(P.ws + WS_BT1), scr, r - IO, lane);
    else p0_transpose_item(P.in[16], DM, DM, nullptr, false, -1, -1, (bf16*)(P.ws + WS_BTO1), scr, r - IO - I1, lane);
    __syncthreads();
}
#define XB_TMO      128
#define XB_XCNT(j)  (256  + 64 * (j))
#define XB_XSUB(j)  (1280 + 64 * (j))
#define XB_XGEN(j)  (2304 + 64 * (j))
#define XB_TOP      3328
#define XB_TOPGEN   3392
#define XCD_BAR_WORDS 3456
#define XB_SPIN_CAP (1u << 18)

__device__ __forceinline__ unsigned xb_ld(unsigned* p)              { return __hip_atomic_load(p, __ATOMIC_RELAXED, __HIP_MEMORY_SCOPE_AGENT); }
__device__ __forceinline__ unsigned xb_add(unsigned* p, unsigned v) { return __hip_atomic_fetch_add(p, v, __ATOMIC_RELAXED, __HIP_MEMORY_SCOPE_AGENT); }
__device__ __forceinline__ unsigned xb_xcc_id() { return (unsigned)__builtin_amdgcn_s_getreg((3 << 11) | 20) & 0xFu; }
#define XB_SPIN(cond, bar) do { unsigned _sp = 0; while (cond) { __builtin_amdgcn_s_sleep(1); \
    if ((++_sp & 255u) == 0u) { if (xb_ld(&(bar)[XB_TMO])) break; if (_sp > XB_SPIN_CAP) { atomicAdd(&(bar)[XB_TMO], 1u); break; } } } } while (0)

struct XcdBarrier {
    unsigned* bar; unsigned x;
    volatile LAS unsigned* st;
};

__device__ __forceinline__ XcdBarrier xcd_barrier_post(unsigned* bar, volatile LAS unsigned* st) {
    XcdBarrier b; b.bar = bar; b.x = xb_xcc_id(); b.st = st;
    if (threadIdx.x == 0) (void)xb_add(&bar[XB_XCNT(b.x)], 1u);
    return b;
}
__device__ __forceinline__ void xcd_barrier_complete(unsigned* bar, unsigned x, unsigned& nloc, unsigned& nx) {
    const unsigned G = gridDim.x * gridDim.y * gridDim.z;
    unsigned sum, cnt, mine, sp = 0u;
    for (;;) {
        sum = 0u; cnt = 0u; mine = 0u;
#pragma unroll
        for (unsigned j = 0; j < 16; ++j) { const unsigned c = xb_ld(&bar[XB_XCNT(j)]); sum += c; cnt += (c > 0u) ? 1u : 0u; mine = (j == x) ? c : mine; }
        if (sum == G) break;
        __builtin_amdgcn_s_sleep(1);
        if ((++sp & 255u) == 0u) { if (xb_ld(&bar[XB_TMO])) break; if (sp > XB_SPIN_CAP) { atomicAdd(&bar[XB_TMO], 1u); break; } }
    }
    nloc = mine > 0u ? mine : 1u; nx = cnt > 0u ? cnt : 1u;
}

__device__ __forceinline__ void xcd_barrier(const XcdBarrier& b) {
    asm volatile("s_waitcnt vmcnt(0)" ::: "memory");
    __syncthreads();
    if (threadIdx.x == 0) {
        unsigned* bar = b.bar;
        __builtin_amdgcn_s_waitcnt(0);
        unsigned nloc = b.st[0], nx = b.st[1];
        if (nloc == 0u) { xcd_barrier_complete(bar, b.x, nloc, nx); b.st[0] = nloc; b.st[1] = nx; }
        const unsigned old = xb_add(&bar[XB_XSUB(b.x)], 1u);
        const unsigned gen = old / nloc;
        if (old + 1u == (gen + 1u) * nloc) {
            __builtin_amdgcn_fence(__ATOMIC_RELEASE, "agent");
            asm volatile("s_waitcnt vmcnt(0)" ::: "memory");
            const unsigned og = xb_add(&bar[XB_TOP], 1u);
            const unsigned tg = og / nx;
            if (og + 1u == (tg + 1u) * nx) xb_add(&bar[XB_TOPGEN], 1u);
            else XB_SPIN(xb_ld(&bar[XB_TOPGEN]) == tg, bar);
            __builtin_amdgcn_fence(__ATOMIC_ACQUIRE, "agent");
            xb_add(&bar[XB_XGEN(b.x)], 1u);
            asm volatile("s_waitcnt vmcnt(0)" ::: "memory");
        } else {
            XB_SPIN(xb_ld(&bar[XB_XGEN(b.x)]) == gen, bar);
            __builtin_amdgcn_fence(__ATOMIC_ACQUIRE, "agent");
            asm volatile("s_waitcnt vmcnt(0)" ::: "memory");
        }
    }
    __syncthreads();
}

__device__ __forceinline__ void unit_A(const Params& P, LAS unsigned char* lds, int bh, int qa, int tid, int lane, int wave) {
    const int b = bh >> 2, h = bh & 3, r32 = lane & 31, hi = lane >> 5;
    const bf16* Zb = (const bf16*)(P.ws + WS_Z) + (size_t)b * SEQ * N0;
    const int c = wave >> 2, j = wave & 3, q0w = 128 * qa + 32 * j, chunk = 2 * qa + (j >> 1);
    const float slope = exp2f(-2.0f * (float)(h + 1));
    const float thr = 150.0f / (slope * LOG2E);
    const int t_lo = max(0, (int)ceilf(((float)(128 * qa) - thr - 63.0f) * (1.0f / 64.0f))), w_lo = max(0, (int)ceilf(((float)q0w - thr - 63.0f) * (1.0f / 64.0f)));
    f32x16 o[4]; float l; att::u32x4 gdum[4];
    att::attn_core<2, 2, 0>(lds, Zb, N0, h * 128 + c * 64, 512 + h * 128, 512 + h * 128 + 64, 1024 + h * 128, q0w, t_lo, 2 * qa + 1, w_lo, chunk, c, -slope * LOG2E, -1, o, ((const float*)(P.ws + WS_CTL))[1], l, -1, gdum);
    const float inv = 1.0f / l;
    LAS f32x4* xs = (LAS f32x4*)lds + j * 1024 + lane;
    if (c == 1) {
#pragma unroll
        for (int i = 0; i < 4; ++i)
#pragma unroll
            for (int r4 = 0; r4 < 4; ++r4) xs[(i * 4 + r4) * 64] = (f32x4){o[i][4 * r4] * inv, o[i][4 * r4 + 1] * inv, o[i][4 * r4 + 2] * inv, o[i][4 * r4 + 3] * inv};
    }
    __syncthreads();
    if (c == 0) {
        const float lam = ((const float*)(P.ws + WS_CTL))[0];
        float ss = 0.f;
#pragma unroll
        for (int i = 0; i < 4; ++i)
#pragma unroll
            for (int r4 = 0; r4 < 4; ++r4) { const f32x4 x1 = xs[(i * 4 + r4) * 64];
#pragma unroll
                for (int e = 0; e < 4; ++e) { const float v = o[i][4 * r4 + e] * inv - lam * x1[e]; o[i][4 * r4 + e] = v; ss += v * v; } }
        ss += __shfl_xor(ss, 32);
        const float rn = 0.8f / sqrtf(ss * (1.0f / 128.0f) + 1e-6f);
        const size_t row = (size_t)b * SEQ + q0w + r32;
        const bf16* grow = (const bf16*)(P.ws + WS_Z) + row * N0 + 1536 + h * 128;
        bf16* orow = (bf16*)(P.ws + WS_MIX) + row * DM + h * 128;
        const float* sg = P.in[10];
#pragma unroll
        for (int i = 0; i < 4; ++i)
#pragma unroll
            for (int jp = 0; jp < 2; ++jp) {
                const int cb = 32 * i + 16 * jp + 8 * hi;
                const v4u L = *(const v4u*)(grow + cb);
                const auto g0 = __builtin_amdgcn_permlane32_swap(L.x, L.z, false, false), g1 = __builtin_amdgcn_permlane32_swap(L.y, L.w, false, false);
                v2u w[2];
#pragma unroll
                for (int q = 0; q < 2; ++q) { const int jj = 2 * jp + q, d = 32 * i + 8 * jj + 4 * hi; const unsigned gx = q ? g0[1] : g0[0], gy = q ? g1[1] : g1[0];
                    const f32x4 s4 = *(const f32x4*)(sg + d);
                    const float a0 = __uint_as_float(gx << 16), a1 = __uint_as_float(gx & 0xffff0000u), a2 = __uint_as_float(gy << 16), a3 = __uint_as_float(gy & 0xffff0000u);
                    w[q].x = att::cvtpk(o[i][4 * jj] * rn * s4[0] * a0, o[i][4 * jj + 1] * rn * s4[1] * a1); w[q].y = att::cvtpk(o[i][4 * jj + 2] * rn * s4[2] * a2, o[i][4 * jj + 3] * rn * s4[3] * a3); }
                const auto s0 = __builtin_amdgcn_permlane32_swap(w[0].x, w[1].x, false, false), s1 = __builtin_amdgcn_permlane32_swap(w[0].y, w[1].y, false, false);
                *(v4u*)(orow + cb) = (v4u){s0[0], s1[0], s0[1], s1[1]};
            }
    }
    __syncthreads();
}
__device__ __forceinline__ void unit_B(const Params& P, LAS unsigned char* lds, int bh, int qb, int tid, int lane, int wave) {
    const int b = bh >> 3, h = bh & 7, r32 = lane & 31, hi = lane >> 5;
    const bf16* Zb = (const bf16*)(P.ws + WS_Z) + (size_t)b * SEQ * N0;
    const int q0w = 256 * qb + 32 * wave, chunk = 4 * qb + (wave >> 1);
    {
        const float* lfs = (const float*)(P.ws + WS_LF) + (size_t)bh * SEQ;
        LAS float* cl = (LAS float*)(lds + att::LDS_CUM);
        LAS float* part = (LAS float*)(lds + MISC_OFF + 256);
        const int n = 256 * (qb + 1); const bool mine = tid * 8 < n;
        f32x4 a4 = (f32x4){0.f, 0.f, 0.f, 0.f}, b4 = a4;
        if (mine) { const f32x4* src = (const f32x4*)(lfs + tid * 8); a4 = src[0]; b4 = src[1]; }
        float v0 = a4[0], v1 = v0 + a4[1], v2 = v1 + a4[2], v3 = v2 + a4[3], v4 = v3 + b4[0], v5 = v4 + b4[1], v6 = v5 + b4[2], v7 = v6 + b4[3];
        float inc = v7;
#pragma unroll
        for (int o_ = 1; o_ < 64; o_ <<= 1) { const float t_ = __shfl_up(inc, o_); if (lane >= o_) inc += t_; }
        if (lane == 63) part[wave] = inc;
        __syncthreads();
        float base = inc - v7;
#pragma unroll
        for (int w_ = 0; w_ < 8; ++w_) if (w_ < wave) base += part[w_];
        if (tid == 32 * qb) part[8] = v0 + base;
        __syncthreads();
        const float cref = part[8];
        if (mine) { LAS f32x4* dst = (LAS f32x4*)(cl + tid * 8);
            dst[0] = (f32x4){(cref - (v0 + base)) * LOG2E, (cref - (v1 + base)) * LOG2E, (cref - (v2 + base)) * LOG2E, (cref - (v3 + base)) * LOG2E};
            dst[1] = (f32x4){(cref - (v4 + base)) * LOG2E, (cref - (v5 + base)) * LOG2E, (cref - (v6 + base)) * LOG2E, (cref - (v7 + base)) * LOG2E}; }
    }
    __syncthreads();
    const float mrow = ((const float*)(P.ws + WS_CTL))[2] + ((const LAS float*)(lds + att::LDS_CUM))[q0w + r32];
    int t_lo, w_lo;
    { const LAS float* cl = (const LAS float*)(lds + att::LDS_CUM); const int ti = lane <= 4 * qb + 3 ? lane : 4 * qb + 3; const float ce = cl[64 * ti + 63];
      const unsigned long long kw = __ballot(ce - cl[q0w] >= -150.0f), kb = __ballot(ce - cl[256 * qb] >= -150.0f);
      w_lo = kw ? (int)__builtin_ctzll(kw) : chunk; t_lo = kb ? (int)__builtin_ctzll(kb) : 4 * qb; if (w_lo > chunk) w_lo = chunk; }
    t_lo = __builtin_amdgcn_readfirstlane(t_lo); w_lo = __builtin_amdgcn_readfirstlane(w_lo);
    f32x16 o[2]; float l; att::u32x4 gpre[4];
    att::attn_core<1, 1, 1>(lds, Zb, N0, 2048 + h * 64, 2560 + h * 64, 0, 3072 + h * 64, q0w, t_lo, 4 * qb + 3, w_lo, chunk, 0, 0.f, chunk, o, mrow, l, 3584 + h * 64, gpre);
    const size_t row = (size_t)b * SEQ + q0w + r32;
    att::store_gated(o, 1.0f / l, gpre, (bf16*)(P.ws + WS_MIX) + row * DM + 512 + h * 64, hi);
}
__device__ __forceinline__ void unit_C(const Params& P, LAS unsigned char* lds, int b, int kvh, int c, int tid, int lane, int wave) {
    const int r32 = lane & 31, hi = lane >> 5, h = kvh * 4 + (wave >> 1);
    const bf16* Zb = (const bf16*)(P.ws + WS_Z) + (size_t)b * SEQ * N1;
    const int q0w = 64 * c + 32 * (wave & 1);
    const int t_lo = (c - 2) > 0 ? c - 2 : 0;
    const float slope = exp2f(-(float)(h + 1));
    const float m = ((const float*)(P.ws + WS_CTL))[3];
    f32x16 o[2]; float l; att::u32x4 gpre[4];
    att::attn_core<1, 1, 2>(lds, Zb, N1, h * 64, 512 + kvh * 64, 0, 640 + kvh * 64, q0w, t_lo, c, t_lo, c, 0, -slope * LOG2E, -1, o, m, l, 768 + h * 64, gpre);
    l += exp2f(P.in[19][h] * LOG2E - m);
    const size_t row = (size_t)b * SEQ + q0w + r32;
    att::store_gated(o, 1.0f / l, gpre, (bf16*)(P.ws + WS_MIX) + row * DM + h * 64, hi);
}
__device__ __forceinline__ void unit_D(const Params& P, LAS unsigned char* lds, int bh, int qb, int tid, int lane, int wave) {
    const int b = bh >> 3, h = bh & 7, r32 = lane & 31, hi = lane >> 5;
    const bf16* Zb = (const bf16*)(P.ws + WS_Z) + (size_t)b * SEQ * N1;
    const int q0w = 256 * qb + 32 * wave, chunk = 4 * qb + (wave >> 1);
    const int t_lo = (4 * qb - 8) > 0 ? 4 * qb - 8 : 0, w_lo = (chunk - 8) > 0 ? chunk - 8 : 0;
    { LAS float* tb = (LAS float*)(lds + att::LDS_TAB); const float* rt = P.in[22] + h * 320;
      const float mh = ((const float*)(P.ws + WS_CTL))[8 + h];
      for (int i = tid; i < 640; i += NTHR) { const int e = 638 - i; tb[i] = rt[e < 319 ? (e < 0 ? 0 : e) : 319] * LOG2E - mh; } }
    const float m = ((const float*)(P.ws + WS_CTL))[8 + h];
    f32x16 o[2]; float l; att::u32x4 gpre[4];
    att::attn_core<1, 1, 3>(lds, Zb, N1, 1280 + h * 64, 1792 + h * 64, 0, 2304 + h * 64, q0w, t_lo, 4 * qb + 3, w_lo, chunk, 0, 0.f, -1, o, m, l, 2816 + h * 64, gpre);
    const size_t row = (size_t)b * SEQ + q0w + r32;
    att::store_gated(o, 1.0f / l, gpre, (bf16*)(P.ws + WS_MIX) + row * DM + 512 + h * 64, hi);
}
__device__ __forceinline__ int queue_next(unsigned* ctr, LAS unsigned char* lds, int tid) {
    volatile LAS int* w = (volatile LAS int*)(lds + MISC_OFF);
    if (tid == 0) w[0] = (int)atomicAdd(ctr, 1u);
    __syncthreads();
    const int it = w[0];
    __syncthreads();
    return it;
}

__global__ void __launch_bounds__(NTHR, 2) trunk_fwd(Params P) {
    extern __shared__ __attribute__((aligned(16))) unsigned char lds_raw[];
    LAS unsigned char* lds = (LAS unsigned char*)lds_raw;
    const int tid = threadIdx.x, lane = tid & 63, wave = __builtin_amdgcn_readfirstlane(tid >> 6);
    const int lo = P.ph_lo, hi_ = P.ph_hi, G = gridDim.x;
    unsigned char* ws = P.ws;
#define IN(k) (lo <= (k) && (k) < hi_)
    { volatile LAS unsigned* mz = (volatile LAS unsigned*)(lds + MISC_OFF); if (tid < 64) mz[tid] = 0u; }
    __syncthreads();
    XcdBarrier bar = xcd_barrier_post((unsigned*)(ws + WS_CTL) + CW_BAR, (volatile LAS unsigned*)(lds + MISC_OFF + 64));
    if (P.ph_hi > 1000) cg::this_grid().sync();
#define SEAM(k) do { if (IN(k) && IN((k) + 1)) { xcd_barrier(bar); } } while (0)
    if (IN(0)) { p0_prologue(P, lds, tid, lane, wave); __syncthreads();
#if PROBE_REP0
        p0_prologue(P, lds, tid, lane, wave); __syncthreads();
#endif
    }
    SEAM(0);
    if (IN(1)) {
        pg8::Gemm g{(const bf16*)(ws + WS_XB), (const bf16*)(ws + WS_BT0), M, N0, DM}; pg8::StaticOrder S; S.init(M, N0, G, (int)blockIdx.x);
        pg8::EpiIn E{(bf16*)(ws + WS_Z), N0, (const float*)(ws + WS_RS0), nullptr,
                     {8, 16, 24, 32, 40, 48, 56, 64}, {1, 2, 0, 3, 1, 2, 0, 3}, {P.in[4], P.in[5], nullptr, nullptr, P.in[11], P.in[12], nullptr, nullptr}, 0, -1, -1};
        pg8::gemm_phase<pg8::EpiIn, pg8::StaticOrder, PG8_ALIGN, PG8_SP2>(lds, g, S, E);
        __syncthreads();
#if PROBE_REP1
        pg8::gemm_phase<pg8::EpiIn, pg8::StaticOrder, PG8_ALIGN, PG8_SP2>(lds, g, S, E);
        __syncthreads();
#endif
    }
    SEAM(1);
    if (IN(2)) {
        unsigned* ctr = (unsigned*)(ws + WS_CTL) + 64;
        int it = (int)blockIdx.x;
        for (;;) {
            if (it >= 1024) break;
            const int pp = it >> 6, r = it & 63;
            if (r < 16) unit_A(P, lds, r, 31 - 2 * pp, tid, lane, wave);
            else if (r < 48) unit_B(P, lds, r - 16, 15 - pp, tid, lane, wave);
            else unit_A(P, lds, r - 48, 30 - 2 * pp, tid, lane, wave);
            it = G + queue_next(ctr, lds, tid);
        }
        while (it < 1024 + LATE_W_ITEMS) { late_weight_item(P, lds, it - 1024, lane, wave); it = G + queue_next(ctr, lds, tid); }
    }
    SEAM(2);
    if (IN(3)) {
        pg8::Gemm g{(const bf16*)(ws + WS_MIX), (const bf16*)(ws + WS_BTO0), M, DM, DM}; pg8::StaticOrder S; S.init(M, DM, G, (int)blockIdx.x);
        pg8::EpiOut E{P.in[0], nullptr, nullptr, (bf16*)(ws + WS_XB), (float*)(ws + WS_SSQ)};
        pg8::gemm_phase<pg8::EpiOut, pg8::StaticOrder, false, PG8_SP2>(lds, g, S, E);
        __syncthreads();
#if PROBE_REP3
        pg8::gemm_phase<pg8::EpiOut, pg8::StaticOrder, false, PG8_SP2>(lds, g, S, E);
        __syncthreads();
#endif
    }
    SEAM(3);
    if (IN(4)) {
        pg8::Gemm g{(const bf16*)(ws + WS_XB), (const bf16*)(ws + WS_BT1), M, 3072, DM}; pg8::StaticOrder S; S.init(M, 3072, G, (int)blockIdx.x);
        pg8::EpiIn E{(bf16*)(ws + WS_Z), N1, nullptr, (const float*)(ws + WS_SSQ),
                     {8, 10, 12, 20, 28, 36, 44, 52}, {1, 2, 0, 3, 1, 2, 0, 3}, {P.in[17], P.in[18], nullptr, nullptr, P.in[20], P.in[21], nullptr, nullptr}, 0, 4, 12};
        pg8::gemm_phase<pg8::EpiIn, pg8::StaticOrder, PG8_ALIGN, PG8_SP2>(lds, g, S, E);
        __syncthreads();
    }
    SEAM(4);
    if (IN(5)) {
        unsigned* late = (unsigned*)(ws + WS_CTL) + 320;
        {
            pg8::Gemm g2{(const bf16*)(ws + WS_XB), (const bf16*)(ws + WS_BT1) + (size_t)3072 * 1024, M, 256, DM}; pg8::StaticOrder S2; S2.init(M, 256, G, (int)blockIdx.x);
            pg8::Unit u0; int n_mine = 0; while (S2.next(n_mine, u0)) ++n_mine;
            const bool mine = n_mine > 0;
            pg8::EpiIn E2{(bf16*)(ws + WS_Z), N1, nullptr, (const float*)(ws + WS_SSQ),
                          {8, 10, 12, 20, 28, 36, 44, 52}, {1, 2, 0, 3, 1, 2, 0, 3}, {P.in[17], P.in[18], nullptr, nullptr, P.in[20], P.in[21], nullptr, nullptr}, 12, 4, 12};
            pg8::gemm_phase<pg8::EpiIn, pg8::StaticOrder, PG8_ALIGN, PG8_SP2>(lds, g2, S2, E2);
            if (mine) {
                asm volatile("s_waitcnt vmcnt(0)" ::: "memory"); __syncthreads();
                if (tid == 0) { __builtin_amdgcn_fence(__ATOMIC_RELEASE, "agent"); asm volatile("s_waitcnt vmcnt(0)" ::: "memory"); (void)xb_add(late, (unsigned)n_mine); }
                __syncthreads();
            }
        }
        bool late_ok = false;
        for (int rep = 0; rep < 1 + PROBE_REP5; ++rep) {
        unsigned* ctr = (unsigned*)(ws + WS_CTL) + 128 + 128 * rep;
        const int NL = G < 64 ? G : 64; const bool owner = (int)blockIdx.x < NL;
#define P5_NEXT() ({ const int n_ = queue_next(ctr, lds, tid); n_ < NL ? n_ : n_ - NL + G; })
        for (int it = owner ? P5_NEXT() : (int)blockIdx.x; it < 1024; it = P5_NEXT()) {
            if (it < 512) { const int bh = it & 31, qb = 15 - (it >> 5); unit_D(P, lds, bh, qb, tid, lane, wave); }
            else {
                const int r = it - 512, half = r >> 8, idx = r & 255, cc = 63 - (idx >> 2), bb = idx & 3;
                if (half && !late_ok) {
                    if (tid == 0) { unsigned sp = 0; while (xb_ld(late) < 64u) { __builtin_amdgcn_s_sleep(2); if (++sp > (1u << 22)) break; }
                        __builtin_amdgcn_fence(__ATOMIC_ACQUIRE, "agent"); asm volatile("s_waitcnt vmcnt(0)" ::: "memory"); }
                    __syncthreads(); late_ok = true;
                }
                unit_C(P, lds, bb, half, cc, tid, lane, wave);
            }
        }
        }
    }
    SEAM(5);
    if (IN(6)) {
        pg8::Gemm g{(const bf16*)(ws + WS_MIX), (const bf16*)(ws + WS_BTO1), M, DM, DM}; pg8::StaticOrder S; S.init(M, DM, G, (int)blockIdx.x);
        pg8::EpiOut E{nullptr, (const bf16*)(ws + WS_XB), P.out, nullptr, nullptr};
        pg8::gemm_phase<pg8::EpiOut, pg8::StaticOrder, false, PG8_SP2>(lds, g, S, E);
    }
#undef IN
#undef SEAM
}

extern "C" void kernel_launch(void* const* d_in, const int* in_sizes, int n_in, void* d_out, int out_size, void* d_ws, size_t ws_size, hipStream_t stream) {
    static int grid = 0;
    if (grid == 0) {
        if (n_in != 23 || out_size != M * DM || ws_size < WS_END) { fprintf(stderr, "kernel_launch: unexpected shapes (n_in %d, out %d, ws %zu)\n", n_in, out_size, ws_size); grid = -1; return; }
        int dev = 0, cus = 0, per_cu = 0;
        hipGetDevice(&dev); hipDeviceGetAttribute(&cus, hipDeviceAttributeMultiprocessorCount, dev);
        if (hipFuncSetAttribute((const void*)trunk_fwd, hipFuncAttributeMaxDynamicSharedMemorySize, LDS_BYTES) != hipSuccess) { fprintf(stderr, "kernel_launch: hipFuncSetAttribute failed\n"); grid = -1; return; }
        if (hipOccupancyMaxActiveBlocksPerMultiprocessor(&per_cu, (const void*)trunk_fwd, NTHR, LDS_BYTES) != hipSuccess || per_cu < 1) { fprintf(stderr, "kernel_launch: occupancy query says %d\n", per_cu); per_cu = 1; }
        (void)hipGetLastError();
        grid = cus * 1;
        if (grid <= 0) grid = 256;
    }
    if (grid < 0) return;
    if (hipMemsetAsync((char*)d_ws + WS_CTL, 0, 65536, stream) != hipSuccess) { fprintf(stderr, "kernel_launch: memset failed\n"); return; }
    Params p{};
    for (int i = 0; i < 23; ++i) p.in[i] = (const float*)d_in[i];
    p.out = (float*)d_out; p.ws = (unsigned char*)d_ws;
#if MK_LAUNCHES == 1
    p.ph_lo = 0; p.ph_hi = 7;
    void* args[] = {&p};
    hipError_t e = hipLaunchCooperativeKernel((const void*)trunk_fwd, dim3(grid), dim3(NTHR), args, LDS_BYTES, stream);
    if (e != hipSuccess) fprintf(stderr, "kernel_launch: cooperative launch failed: %s (grid %d)\n", hipGetErrorString(e), grid);
#else
    for (int ph = 0; ph < 7; ++ph) { p.ph_lo = ph; p.ph_hi = ph + 1; hipLaunchKernelGGL(trunk_fwd, dim3(grid), dim3(NTHR), LDS_BYTES, stream, p); }
#endif
}
```

```cpp
#include <hip/hip_runtime.h>
#include <hip/hip_cooperative_groups.h>
#include <cstdio>
#include <cstdint>
namespace cg = cooperative_groups;
#ifndef PROBE_REP0
#define PROBE_REP0 0
#endif
#ifndef PROBE_REP3
#define PROBE_REP3 0
#endif
#ifndef PROBE_REP4
#define PROBE_REP4 0
#endif
#ifndef PROBE_REP1
#define PROBE_REP1 0
#endif
#ifndef PROBE_REP2
#define PROBE_REP2 0
#endif
#ifndef PROBE_REP5
#define PROBE_REP5 0
#endif
#ifndef MK_LAUNCHES
#define MK_LAUNCHES 1
#endif
namespace pg8 {
#define PG8_LAS __attribute__((address_space(3)))
typedef unsigned short bf16_t;
typedef short bf16x8 __attribute__((ext_vector_type(8)));
typedef float f32x4 __attribute__((ext_vector_type(4)));
typedef unsigned u32x4 __attribute__((ext_vector_type(4)));
constexpr int BM = 256, BK = 64, HALF = 128, HTB = HALF * BK * 2  , STAGE_BYTES = 8 * HTB, NXCD = 8, WGM = 8;

__host__ __device__ __forceinline__ int lds_byte(int r, int c) { const int st = (r >> 4) * 2 + (c >> 5), rr = r & 15, cc = c & 31, ob = rr * 64 + cc * 2; return st * 1024 + (ob ^ (((ob >> 9) & 1) << 5)); }
__host__ __device__ __forceinline__ void stage_rc(int b, int& R, int& C) { const int st = b / 1024, sb = b % 1024, swz = sb ^ (((sb >> 9) & 1) << 5); R = (st >> 1) * 16 + swz / 64; C = (st & 1) * 32 + (swz % 64) / 2; }
__host__ __device__ __forceinline__ int perm32(int rho) { const int n = rho >> 4, i = rho & 15; return 8 * (i >> 2) + 4 * n + (i & 3); }

struct Unit { int pm, pn; };
struct Gemm { const bf16_t* A; const bf16_t* Bt; int M, N, K; };

struct StaticOrder {
    int nM, nN, nwg, G, c;
    __host__ __device__ void init(int M, int N, int G_, int c_) { nM = M / BM; nN = N / BM; nwg = nM * nN; G = G_; c = c_; }
    __host__ __device__ bool next(int i, Unit& u) const {
        const long L = (long)i * G + c; if (L >= nwg) return false;
        int wgid = (int)L; { const int q = nwg / NXCD, r = nwg % NXCD, xcd = wgid % NXCD, off = wgid / NXCD; wgid = (xcd < r ? xcd * (q + 1) : r * (q + 1) + (xcd - r) * q) + off; }
        const int nig = WGM * nN, gid = wgid / nig, fm = gid * WGM, gsz = (nM - fm) < WGM ? (nM - fm) : WGM;
        u.pm = fm + ((wgid % nig) % gsz); u.pn = (wgid % nig) / gsz; return true;
    }
    __device__ __forceinline__ void a_ready(const Unit&) const {}
    __device__ __forceinline__ void done(const Unit&) const {}
};

__device__ __forceinline__ unsigned cvt_pk_bf16(float lo, float hi) { unsigned r; asm volatile("v_cvt_pk_bf16_f32 %0, %1, %2" : "=v"(r) : "v"(lo), "v"(hi)); return r; }
typedef float f32x2 __attribute__((ext_vector_type(2)));
typedef unsigned u32x2 __attribute__((ext_vector_type(2)));
constexpr float QK_C2 = 0.125f * 1.4426950408889634f;
struct EpiIn {
    static constexpr bool PERM = true, AFTER_DRAIN = false;
    bf16_t* O; int ldc; const float* rs; const float* ssq;
    int seg_end[8]; int seg_mode[8]; const float* seg_g[8];
    int pn_off, sw_a, sw_b;
    __device__ __forceinline__ void operator()(const f32x4 (&acc)[2][2][4][2], const Unit& u, int wr, int wc, int fr, int fq) const {
        int lt = u.pn + pn_off; lt = (lt == sw_a) ? sw_b : (lt == sw_b ? sw_a : lt);
        const int gidx = lt * 4 + wc;
        int mode = 0; const float* g = nullptr;
#pragma unroll
        for (int s = 7; s >= 0; --s) if (gidx < seg_end[s]) { mode = seg_mode[s]; g = seg_g[s]; }
        f32x4 gv[2][2];
#pragma unroll
        for (int bj = 0; bj < 2; ++bj)
#pragma unroll
            for (int n = 0; n < 2; ++n) gv[bj][n] = (mode == 1 || mode == 2) ? *(const f32x4*)(g + 32 * bj + 8 * fq + 4 * n) : (f32x4){1.f, 1.f, 1.f, 1.f};
        const float qs = (mode == 1) ? QK_C2 : 1.0f;
        float rr[2][4];
        if (rs) {
#pragma unroll
            for (int ai = 0; ai < 2; ++ai)
#pragma unroll
                for (int m = 0; m < 4; ++m) rr[ai][m] = rs[u.pm * BM + ai * HALF + wr * 64 + m * 16 + fr];
        }
        asm volatile("" ::: "memory");
#pragma unroll
        for (int ai = 0; ai < 2; ++ai) {
            if (!rs) {
                f32x4 sp[4][4];
#pragma unroll
                for (int m = 0; m < 4; ++m) { const f32x4* p_ = (const f32x4*)(ssq + (size_t)(u.pm * BM + ai * HALF + wr * 64 + m * 16 + fr) * 16);
#pragma unroll
                    for (int q = 0; q < 4; ++q) sp[m][q] = p_[q]; }
                asm volatile("" ::: "memory");
#pragma unroll
                for (int m = 0; m < 4; ++m) { const f32x4 a = sp[m][0], b = sp[m][1], c = sp[m][2], d = sp[m][3];
                    const float t = ((a[0] + a[1]) + (a[2] + a[3])) + ((b[0] + b[1]) + (b[2] + b[3])) + ((c[0] + c[1]) + (c[2] + c[3])) + ((d[0] + d[1]) + (d[2] + d[3]));
                    rr[ai][m] = __builtin_amdgcn_rsqf(t * (1.0f / 1024.0f) + 1e-6f); }
            }
#pragma unroll
            for (int m = 0; m < 4; ++m) {
                const int row = u.pm * BM + ai * HALF + wr * 64 + m * 16 + fr;
                const float r = rr[ai][m];
                f32x4 v[2][2];
#pragma unroll
                for (int bj = 0; bj < 2; ++bj)
#pragma unroll
                    for (int n = 0; n < 2; ++n) v[bj][n] = acc[ai][bj][m][n] * r;
                if (mode == 1 || mode == 2) {
                    float ss = 0.f;
#pragma unroll
                    for (int bj = 0; bj < 2; ++bj)
#pragma unroll
                        for (int n = 0; n < 2; ++n) { const f32x4 x = v[bj][n]; ss += (x[0] * x[0] + x[1] * x[1]) + (x[2] * x[2] + x[3] * x[3]); }
                    ss += __shfl_xor(ss, 16); ss += __shfl_xor(ss, 32);
                    const float rn = qs * __builtin_amdgcn_rsqf(ss * (1.0f / 64.0f) + 1e-6f);
#pragma unroll
                    for (int bj = 0; bj < 2; ++bj)
#pragma unroll
                        for (int n = 0; n < 2; ++n) v[bj][n] = v[bj][n] * rn * gv[bj][n];
                } else if (mode == 3) {
#pragma unroll
                    for (int bj = 0; bj < 2; ++bj)
#pragma unroll
                        for (int n = 0; n < 2; ++n)
#pragma unroll
                            for (int e = 0; e < 4; ++e) { const float x = v[bj][n][e]; v[bj][n][e] = x * __builtin_amdgcn_rcpf(1.0f + __builtin_amdgcn_exp2f(x * -1.4426950408889634f)); }
                }
                bf16_t* rowp = O + (size_t)row * ldc + lt * BM + wc * 64 + 8 * fq;
#pragma unroll
                for (int bj = 0; bj < 2; ++bj) { u32x4 w; w.x = cvt_pk_bf16(v[bj][0][0], v[bj][0][1]); w.y = cvt_pk_bf16(v[bj][0][2], v[bj][0][3]); w.z = cvt_pk_bf16(v[bj][1][0], v[bj][1][1]); w.w = cvt_pk_bf16(v[bj][1][2], v[bj][1][3]);
                    *(u32x4*)(rowp + bj * 32) = w; }
            }
        }
    }
};
struct EpiOut {
    static constexpr bool PERM = true, AFTER_DRAIN = false;
    const float* base; const bf16_t* base16; float* out; bf16_t* xb; float* ssq;
    __device__ __forceinline__ void operator()(const f32x4 (&acc)[2][2][4][2], const Unit& u, int wr, int wc, int fr, int fq) const {
        const int col0 = u.pn * BM + wc * 32 + 8 * fq;
#pragma unroll
        for (int ai = 0; ai < 2; ++ai) {
            f32x4 pre[4][2][2];
#pragma unroll
            for (int m = 0; m < 4; ++m) { const size_t off = (size_t)(u.pm * BM + ai * HALF + wr * 64 + m * 16 + fr) * 1024 + col0;
#pragma unroll
                for (int bj = 0; bj < 2; ++bj) {
                    if (base16) { const u32x4 w = *(const u32x4*)(base16 + off + bj * HALF);
                        pre[m][bj][0] = (f32x4){__uint_as_float(w.x << 16), __uint_as_float(w.x & 0xffff0000u), __uint_as_float(w.y << 16), __uint_as_float(w.y & 0xffff0000u)};
                        pre[m][bj][1] = (f32x4){__uint_as_float(w.z << 16), __uint_as_float(w.z & 0xffff0000u), __uint_as_float(w.w << 16), __uint_as_float(w.w & 0xffff0000u)}; }
                    else { pre[m][bj][0] = *(const f32x4*)(base + off + bj * HALF); pre[m][bj][1] = *(const f32x4*)(base + off + bj * HALF + 4); } } }
            asm volatile("" ::: "memory");
#pragma unroll
            for (int m = 0; m < 4; ++m) {
                const int row = u.pm * BM + ai * HALF + wr * 64 + m * 16 + fr;
                const size_t off = (size_t)row * 1024 + col0;
                float ss = 0.f;
#pragma unroll
                for (int bj = 0; bj < 2; ++bj) {
                    const f32x4 o0 = pre[m][bj][0] + acc[ai][bj][m][0], o1 = pre[m][bj][1] + acc[ai][bj][m][1];
                    if (out) { *(f32x4*)(out + off + bj * HALF) = o0; *(f32x4*)(out + off + bj * HALF + 4) = o1; }
                    ss += (o0[0] * o0[0] + o0[1] * o0[1]) + (o0[2] * o0[2] + o0[3] * o0[3]) + (o1[0] * o1[0] + o1[1] * o1[1]) + (o1[2] * o1[2] + o1[3] * o1[3]);
                    if (xb) { u32x4 w; w.x = cvt_pk_bf16(o0[0], o0[1]); w.y = cvt_pk_bf16(o0[2], o0[3]); w.z = cvt_pk_bf16(o1[0], o1[1]); w.w = cvt_pk_bf16(o1[2], o1[3]);
                        *(u32x4*)(xb + off + bj * HALF) = w; }
                }
                if (ssq) { ss += __shfl_xor(ss, 16); ss += __shfl_xor(ss, 32); if (fq == 0) ssq[(size_t)row * 16 + u.pn * 4 + wc] = ss; }
            }
            asm volatile("" ::: "memory");
        }
    }
};

template <class Epi, class Sched, bool ALIGN_EPI = false, bool SP2 = false>
__device__ __forceinline__ void gemm_phase(PG8_LAS unsigned char* lds, const Gemm g, const Sched& S, const Epi& E) {
    const int tid = threadIdx.x, wid = __builtin_amdgcn_readfirstlane(tid >> 6), lane = tid & 63, wr = wid >> 2, wc = wid & 3, fr = lane & 15, fq = lane >> 4;
    const int K = g.K, nt = K / BK;
    unsigned voffA[2], voffB[2];
#pragma unroll
    for (int i = 0; i < 2; ++i) { int R, C; stage_rc(tid * 16 + i * 8192, R, C); const int Rb = Epi::PERM ? ((R & ~31) + perm32(R & 31)) : R;
        voffA[i] = (unsigned)(R * K + C) * 2u; voffB[i] = (unsigned)(Rb * K + C) * 2u; }
    const size_t kstep = (size_t)(BK * 2);
    const size_t hstep = (size_t)HALF * K * 2;
    const size_t tstep = 2 * hstep;
    const unsigned ldsw = (unsigned)wid * 1024u;
    const int aoff = lds_byte(wr * 64 + fr, fq * 8), boff = lds_byte(wc * 32 + fr, fq * 8);
#define PG8_SA(b, h) (((b) * 2 + (h)) * HTB)
#define PG8_SB(b, h) ((4 + (b) * 2 + (h)) * HTB)
#define PG8_STAGE(bufoff, gbase, voff) do { _Pragma("unroll") for (int _i = 0; _i < 2; ++_i) \
        __builtin_amdgcn_global_load_lds((const unsigned*)((const char*)(gbase) + (voff)[_i]), (PG8_LAS unsigned*)(lds + (bufoff) + ldsw + _i * 8192), 16, 0, 0); } while (0)
#define PG8_LDA(dst, b, h) do { _Pragma("unroll") for (int m = 0; m < 4; ++m) _Pragma("unroll") for (int k = 0; k < 2; ++k) dst[m][k] = *(const PG8_LAS bf16x8*)(lds + PG8_SA(b, h) + aoff + m * 2048 + k * 1024); } while (0)
#define PG8_LDB(dst, b, h) do { _Pragma("unroll") for (int n = 0; n < 2; ++n) _Pragma("unroll") for (int k = 0; k < 2; ++k) dst[n][k] = *(const PG8_LAS bf16x8*)(lds + PG8_SB(b, h) + boff + n * 2048 + k * 1024); } while (0)
#define PG8_MMA(ai, bj, At, Bt) do { __builtin_amdgcn_s_setprio(1); _Pragma("unroll") for (int m = 0; m < 4; ++m) _Pragma("unroll") for (int n = 0; n < 2; ++n) _Pragma("unroll") for (int k = 0; k < 2; ++k) \
        acc[ai][bj][m][n] = __builtin_amdgcn_mfma_f32_16x16x32_bf16(Bt[n][k], At[m][k], acc[ai][bj][m][n], 0, 0, 0); __builtin_amdgcn_s_setprio(0); } while (0)
#define PG8_WAIT_V(n) asm volatile("s_waitcnt vmcnt(" #n ")" ::: "memory")
#define PG8_WAIT_L(n) asm volatile("s_waitcnt lgkmcnt(" #n ")" ::: "memory")
#define PG8_BAR __builtin_amdgcn_s_barrier()
#define PG8_SCHED __builtin_amdgcn_sched_barrier(0)
    Unit cur, nxt; int ui = 0;
    if (!S.next(0, cur)) return;
    f32x4 acc[2][2][4][2];
#pragma unroll
    for (int a = 0; a < 2; ++a)
#pragma unroll
        for (int b = 0; b < 2; ++b)
#pragma unroll
            for (int m = 0; m < 4; ++m)
#pragma unroll
                for (int n = 0; n < 2; ++n) acc[a][b][m][n] = (f32x4){0.f, 0.f, 0.f, 0.f};
    bf16x8 At[4][2], B0[2][2], B1[2][2];
    const char* cA = (const char*)g.A + (size_t)cur.pm * tstep; const char* cB = (const char*)g.Bt + (size_t)cur.pn * tstep;
    S.a_ready(cur);
    if constexpr (SP2) {
        PG8_STAGE(PG8_SB(0, 0), cB, voffB); PG8_STAGE(PG8_SB(0, 1), cB + hstep, voffB); PG8_STAGE(PG8_SA(0, 0), cA, voffA); PG8_STAGE(PG8_SA(0, 1), cA + hstep, voffA);
        if (wr == 1) PG8_BAR;
        PG8_WAIT_V(2); PG8_BAR;
        PG8_STAGE(PG8_SB(1, 0), cB + kstep, voffB); PG8_STAGE(PG8_SA(1, 0), cA + kstep, voffA); PG8_STAGE(PG8_SB(1, 1), cB + hstep + kstep, voffB);
        PG8_WAIT_V(6); PG8_BAR;
    } else {
        PG8_STAGE(PG8_SB(0, 0), cB, voffB); PG8_STAGE(PG8_SA(0, 0), cA, voffA); PG8_STAGE(PG8_SB(0, 1), cB + hstep, voffB); PG8_STAGE(PG8_SA(0, 1), cA + hstep, voffA);
        if (wr == 1) PG8_BAR;
        PG8_WAIT_V(4); PG8_BAR;
        PG8_STAGE(PG8_SB(1, 0), cB + kstep, voffB); PG8_STAGE(PG8_SA(1, 0), cA + kstep, voffA); PG8_STAGE(PG8_SB(1, 1), cB + hstep + kstep, voffB);
        PG8_WAIT_V(6); PG8_BAR;
    }
    for (;;) {
        const bool has_next = S.next(ui + 1, nxt);
        const char* nA = has_next ? (const char*)g.A + (size_t)nxt.pm * tstep : cA; const char* nB = has_next ? (const char*)g.Bt + (size_t)nxt.pn * tstep : cB;
        for (int t = 0; t < nt; t += 2) {
            const bool last = (t == nt - 2);
            const char* a1 = cA + (size_t)(t + 1) * kstep;
            const char* a2 = last ? nA : cA + (size_t)(t + 2) * kstep; const char* b2 = last ? nB : cB + (size_t)(t + 2) * kstep;
            const char* a3 = a2 + kstep; const char* b3 = b2 + kstep;
            if (last && has_next) S.a_ready(nxt);
            if constexpr (SP2) {
            PG8_LDB(B0, 0, 0); PG8_LDB(B1, 0, 1); PG8_SCHED; PG8_LDA(At, 0, 0); PG8_STAGE(PG8_SA(1, 1), a1 + hstep, voffA);
            PG8_WAIT_V(8); PG8_WAIT_L(0); PG8_BAR; PG8_MMA(0, 0, At, B0); PG8_MMA(0, 1, At, B1); PG8_BAR; PG8_SCHED;
            PG8_LDA(At, 0, 1); PG8_STAGE(PG8_SB(0, 0), b2, voffB); PG8_STAGE(PG8_SB(0, 1), b2 + hstep, voffB); PG8_STAGE(PG8_SA(0, 0), a2, voffA);
            PG8_WAIT_V(8); PG8_WAIT_L(0); PG8_BAR; PG8_MMA(1, 0, At, B0); PG8_MMA(1, 1, At, B1); PG8_BAR; PG8_SCHED;
            PG8_LDB(B0, 1, 0); PG8_LDB(B1, 1, 1); PG8_SCHED; PG8_LDA(At, 1, 0); PG8_STAGE(PG8_SA(0, 1), a2 + hstep, voffA);
            PG8_WAIT_V(8); PG8_WAIT_L(0); PG8_BAR; PG8_MMA(0, 0, At, B0); PG8_MMA(0, 1, At, B1); PG8_BAR; PG8_SCHED;
            PG8_LDA(At, 1, 1); PG8_STAGE(PG8_SB(1, 0), b3, voffB); PG8_STAGE(PG8_SB(1, 1), b3 + hstep, voffB); PG8_STAGE(PG8_SA(1, 0), a3, voffA);
            PG8_WAIT_V(8); PG8_WAIT_L(0); PG8_BAR; PG8_MMA(1, 0, At, B0); PG8_MMA(1, 1, At, B1); PG8_BAR; PG8_SCHED;
            } else {
            PG8_LDB(B0, 0, 0); PG8_SCHED; PG8_LDA(At, 0, 0); PG8_STAGE(PG8_SA(1, 1), a1 + hstep, voffA);
            PG8_WAIT_L(8); PG8_BAR; PG8_WAIT_L(0); PG8_MMA(0, 0, At, B0); PG8_BAR; PG8_SCHED;
            PG8_LDB(B1, 0, 1); PG8_STAGE(PG8_SB(0, 0), b2, voffB);
            PG8_BAR; PG8_WAIT_L(0); PG8_MMA(0, 1, At, B1); PG8_BAR;
            PG8_LDA(At, 0, 1); PG8_STAGE(PG8_SA(0, 0), a2, voffA);
            PG8_BAR; PG8_WAIT_L(0); PG8_MMA(1, 0, At, B0); PG8_BAR; PG8_SCHED;
            PG8_STAGE(PG8_SB(0, 1), b2 + hstep, voffB);
            PG8_WAIT_V(6); PG8_BAR; PG8_MMA(1, 1, At, B1); PG8_BAR;
            PG8_LDB(B0, 1, 0); PG8_SCHED; PG8_LDA(At, 1, 0); PG8_STAGE(PG8_SA(0, 1), a2 + hstep, voffA);
            PG8_WAIT_L(8); PG8_BAR; PG8_WAIT_L(0); PG8_MMA(0, 0, At, B0); PG8_BAR; PG8_SCHED;
            PG8_LDB(B1, 1, 1); PG8_STAGE(PG8_SB(1, 0), b3, voffB);
            PG8_BAR; PG8_WAIT_L(0); PG8_MMA(0, 1, At, B1); PG8_BAR;
            PG8_LDA(At, 1, 1); PG8_STAGE(PG8_SA(1, 0), a3, voffA);
            PG8_BAR; PG8_WAIT_L(0); PG8_MMA(1, 0, At, B0); PG8_BAR; PG8_SCHED;
            PG8_STAGE(PG8_SB(1, 1), b3 + hstep, voffB);
            PG8_WAIT_V(6); PG8_BAR; PG8_MMA(1, 1, At, B1); PG8_BAR;
            }
        }
        if constexpr (ALIGN_EPI) { if (wr == 0) PG8_BAR; }
        if constexpr (!Epi::AFTER_DRAIN) { E(acc, cur, wr, wc, fr, fq); S.done(cur); }
        if (!has_next) break;
#pragma unroll
        for (int a = 0; a < 2; ++a)
#pragma unroll
            for (int b = 0; b < 2; ++b)
#pragma unroll
                for (int m = 0; m < 4; ++m)
#pragma unroll
                    for (int n = 0; n < 2; ++n) acc[a][b][m][n] = (f32x4){0.f, 0.f, 0.f, 0.f};
        cur = nxt; cA = nA; cB = nB; ++ui;
        if constexpr (ALIGN_EPI) { if (wr == 1) PG8_BAR; }
    }
    PG8_WAIT_V(0);
    if constexpr (!ALIGN_EPI) { if (wr == 0) PG8_BAR; }
    PG8_BAR;
    if constexpr (Epi::AFTER_DRAIN) { E.fused(acc, cur, wr, wc, fr, fq, lds, wid, lane); S.done(cur); }
#undef PG8_SA
#undef PG8_SB
#undef PG8_STAGE
#undef PG8_LDA
#undef PG8_LDB
#undef PG8_MMA
#undef PG8_WAIT_V
#undef PG8_WAIT_L
#undef PG8_BAR
#undef PG8_SCHED
}
}
#define PG8_SP2 true
#define PG8_ALIGN true
namespace att {
typedef unsigned short bf16_t;
typedef __attribute__((address_space(3))) unsigned char* lptr;
typedef __attribute__((address_space(3))) const unsigned char* lcptr;
typedef short bf16x8 __attribute__((ext_vector_type(8)));
typedef short s16x4 __attribute__((ext_vector_type(4)));
typedef float f32x16 __attribute__((ext_vector_type(16)));
typedef float f32x4 __attribute__((ext_vector_type(4)));
typedef unsigned u32x4 __attribute__((ext_vector_type(4)));
typedef unsigned u32x2 __attribute__((ext_vector_type(2)));
typedef float f32x2_t __attribute__((ext_vector_type(2)));
typedef __bf16 bf16x2_t __attribute__((ext_vector_type(2)));
constexpr float LOG2E = 1.4426950408889634f;
constexpr int SLOT = 32768, LDS_CUM = 65536, LDS_TAB = 81920;
__device__ __forceinline__ unsigned cvtpk(float lo, float hi) { f32x2_t v = {lo, hi}; bf16x2_t b = __builtin_convertvector(v, bf16x2_t); return __builtin_bit_cast(unsigned, b); }
__device__ __forceinline__ float bf2f(unsigned short h) { return __uint_as_float(((unsigned)h) << 16); }
__device__ __forceinline__ void glds16(const void* gsrc, unsigned lds_dst) { unsigned keep;
    asm volatile("s_mov_b32 %0, m0\n\ts_mov_b32 m0, %2\n\ts_nop 0\n\tglobal_load_lds_dwordx4 %1, off\n\ts_mov_b32 m0, %0" : "=&s"(keep) : "v"(gsrc), "s"(lds_dst) : "memory"); }
__device__ __forceinline__ float fadd_s(float a, float b) { return a + b; }
__device__ __forceinline__ float fsub_s(float a, float b) { return a - b; }
__device__ __forceinline__ s16x4 vtr(lcptr p) { return __builtin_bit_cast(s16x4, __builtin_amdgcn_ds_read_tr16_b64_v4i16((__attribute__((address_space(3))) s16x4*)p)); }

template <int VD, int NK, int MODE>
__device__ __forceinline__ void attn_core(lptr lds, const bf16_t* Zb, int ldz, int qcol, int kcol0, int kcol1, int vcol, int q0w,
                                          int t_lo, int t_hi, int w_lo, int w_hi, int ksel, float nsl, int diag_t,
                                          f32x16 (&o)[2 * VD], float mref, float& l_run, int gcol, u32x4 (&gpre)[4]) {
    const int tid = threadIdx.x, lane = tid & 63, r32 = lane & 31, hi = lane >> 5;
    const int wv_ = __builtin_amdgcn_readfirstlane(tid >> 6);
    const int krow_ = 8 * wv_ + (lane >> 3), kchk_ = (lane & 7) ^ ((krow_ >> 1) & 7);
    const bf16_t* ksrc0 = Zb + (size_t)krow_ * ldz + kcol0 + kchk_ * 8;
    const bf16_t* ksrc1 = Zb + (size_t)krow_ * ldz + kcol1 + kchk_ * 8;
    const bf16_t* vsrc = Zb + (size_t)krow_ * ldz + vcol + ((lane & 7) ^ (4 * ((lane >> 4) & 1))) * 8;
    const unsigned lds0 = (unsigned)(uintptr_t)lds + (unsigned)wv_ * 1024u;
#define ATT_DMA(t, sl) do { const size_t go_ = (size_t)(t) * 64 * ldz; const unsigned d_ = (unsigned)__builtin_amdgcn_readfirstlane(lds0 + (unsigned)(sl) * SLOT); \
        glds16(ksrc0 + go_, d_); if (NK == 2) glds16(ksrc1 + go_, d_ + 8192u); glds16(vsrc + go_, d_ + 16384u); if (VD == 2) glds16(vsrc + go_ + 64, d_ + 24576u); } while (0)
#define ATT_DMA_WAIT() asm volatile("s_waitcnt vmcnt(0)" ::: "memory")
    bf16x8 qr[4];
    { const bf16_t* qp = Zb + (size_t)(q0w + r32) * ldz + qcol + hi * 8;
#pragma unroll
      for (int d0 = 0; d0 < 4; ++d0) qr[d0] = *(const bf16x8*)(qp + d0 * 16); }
#pragma unroll
    for (int i = 0; i < 2 * VD; ++i) o[i] = f32x16{};
    const float m = mref; float l = 0.f;
    const int qabs = q0w + r32;
    unsigned koff[4];
#pragma unroll
    for (int d0 = 0; d0 < 4; ++d0) koff[d0] = (unsigned)(ksel * 8192 + r32 * 128 + (((2 * d0 + hi) ^ ((r32 >> 1) & 7)) << 4));
    unsigned vfr[2];
#pragma unroll
    for (int dh = 0; dh < 2; ++dh) vfr[dh] = (unsigned)(16384 + (4 * hi + ((lane & 15) >> 2)) * 128 + ((dh ^ ((lane >> 3) & 1)) * 64) + ((lane >> 4) & 1) * 32 + (lane & 3) * 8);
    if (gcol >= 0) {
        const bf16_t* gp = Zb + (size_t)(q0w + r32) * ldz + gcol + 8 * hi;
#pragma unroll
        for (int i = 0; i < 4; ++i) gpre[i] = *(const u32x4*)(gp + 32 * (i >> 1) + 16 * (i & 1));
    }
    ATT_DMA(t_lo, 0); ATT_DMA_WAIT();
    if (gcol >= 0) asm volatile("" : "+v"(gpre[0]), "+v"(gpre[1]), "+v"(gpre[2]), "+v"(gpre[3]));
    __syncthreads();
    const float nnsl = -nsl;
    for (int t = t_lo; t <= t_hi; ++t) {
        const int cur = (t - t_lo) & 1;
        const bool act_ = (t >= w_lo && t <= w_hi);
        if (!act_) { if (t < t_hi) ATT_DMA(t + 1, cur ^ 1); }
        if (act_) {
            lcptr sb = (lcptr)(lds + cur * SLOT);
            bf16x8 kf[8];
#pragma unroll
            for (int d0 = 0; d0 < 4; ++d0) { kf[2 * d0] = *(const __attribute__((address_space(3))) bf16x8*)(sb + koff[d0]); kf[2 * d0 + 1] = *(const __attribute__((address_space(3))) bf16x8*)(sb + koff[d0] + 4096); }
            s16x4 vlo[8], vhh[8];
#pragma unroll
            for (int i = 0; i < 8; ++i) { vlo[i] = vtr(sb + vfr[i >> 2] + (i & 3) * 2048); vhh[i] = vtr(sb + vfr[i >> 2] + (i & 3) * 2048 + 1024); }
            __builtin_amdgcn_sched_barrier(0);
            f32x16 p0, p1;
            if (MODE == 0 || MODE == 2) {
                const float fq = (float)(qabs - 64 * t - 4 * hi);
                if (t == w_hi) {
#pragma unroll
                    for (int r = 0; r < 16; ++r) { const float c = (float)((r & 3) + 8 * (r >> 2));
                        p0[r] = __builtin_fmaf(nsl, __builtin_fabsf(fq - c), -m); p1[r] = __builtin_fmaf(nsl, __builtin_fabsf(fq - c - 32.0f), -m); }
                } else {
                    const float sh = __builtin_fmaf(nsl, fq, -m), n8 = 8.0f * nnsl, n32 = 32.0f * nnsl;
                    float bj_ = sh;
#pragma unroll
                    for (int j = 0; j < 4; ++j) { p0[4 * j] = bj_; p0[4 * j + 1] = fadd_s(p0[4 * j], nnsl); p0[4 * j + 2] = fadd_s(p0[4 * j + 1], nnsl); p0[4 * j + 3] = fadd_s(p0[4 * j + 2], nnsl);
                        if (j < 3) bj_ = fadd_s(bj_, n8); }
#pragma unroll
                    for (int r = 0; r < 16; ++r) p1[r] = fadd_s(p0[r], n32);
                }
            } else if (MODE == 1) {
                const __attribute__((address_space(3))) float* cl = (const __attribute__((address_space(3))) float*)(lds + LDS_CUM) + 64 * t + 4 * hi;
#pragma unroll
                for (int j = 0; j < 4; ++j) { const f32x4 c0 = *(const __attribute__((address_space(3))) f32x4*)(cl + 8 * j), c1 = *(const __attribute__((address_space(3))) f32x4*)(cl + 8 * j + 32);
#pragma unroll
                    for (int e = 0; e < 4; ++e) { p0[4 * j + e] = fsub_s(c0[e], m); p1[4 * j + e] = fsub_s(c1[e], m); } }
            } else {
                const __attribute__((address_space(3))) float* tb = (const __attribute__((address_space(3))) float*)(lds + LDS_TAB) + (575 - (qabs - 64 * t - 4 * hi));
#pragma unroll
                for (int r = 0; r < 16; ++r) { const int c = (r & 3) + 8 * (r >> 2); p0[r] = tb[c]; p1[r] = tb[c + 32]; }
            }
#pragma unroll
            for (int d0 = 0; d0 < 4; ++d0) {
                p0 = __builtin_amdgcn_mfma_f32_32x32x16_bf16(kf[2 * d0], qr[d0], p0, 0, 0, 0);
                p1 = __builtin_amdgcn_mfma_f32_32x32x16_bf16(kf[2 * d0 + 1], qr[d0], p1, 0, 0, 0);
            }
            if (t < t_hi) ATT_DMA(t + 1, cur ^ 1);

            if (MODE == 1) { if (t == diag_t) { const int qrel = (qabs & 63) - 4 * hi;
#pragma unroll
                    for (int r = 0; r < 16; ++r) { const int kv = (r & 3) + 8 * (r >> 2); if (kv > qrel) p0[r] = -INFINITY; if (kv + 32 > qrel) p1[r] = -INFINITY; } } }
            float sa = 0.f, sb_ = 0.f;
#pragma unroll
            for (int r = 0; r < 16; ++r) { p0[r] = __builtin_amdgcn_exp2f(p0[r]); p1[r] = __builtin_amdgcn_exp2f(p1[r]); sa = fadd_s(sa, p0[r]); sb_ = fadd_s(sb_, p1[r]); }
            l += sa + sb_;
            u32x4 pw[4];
            pw[0] = (u32x4){cvtpk(p0[0], p0[1]), cvtpk(p0[2], p0[3]), cvtpk(p0[4], p0[5]), cvtpk(p0[6], p0[7])};
            pw[1] = (u32x4){cvtpk(p0[8], p0[9]), cvtpk(p0[10], p0[11]), cvtpk(p0[12], p0[13]), cvtpk(p0[14], p0[15])};
            pw[2] = (u32x4){cvtpk(p1[0], p1[1]), cvtpk(p1[2], p1[3]), cvtpk(p1[4], p1[5]), cvtpk(p1[6], p1[7])};
            pw[3] = (u32x4){cvtpk(p1[8], p1[9]), cvtpk(p1[10], p1[11]), cvtpk(p1[12], p1[13]), cvtpk(p1[14], p1[15])};
#pragma unroll
            for (int i = 0; i < 8; ++i) { const bf16x8 vf = (bf16x8){vlo[i][0], vlo[i][1], vlo[i][2], vlo[i][3], vhh[i][0], vhh[i][1], vhh[i][2], vhh[i][3]};
                o[i >> 2] = __builtin_amdgcn_mfma_f32_32x32x16_bf16(vf, __builtin_bit_cast(bf16x8, pw[i & 3]), o[i >> 2], 0, 0, 0); }
            if (VD == 2) {
#pragma unroll
                for (int i = 0; i < 8; ++i) { const s16x4 lo = vtr(sb + vfr[i >> 2] + 8192 + (i & 3) * 2048), hh = vtr(sb + vfr[i >> 2] + 8192 + (i & 3) * 2048 + 1024);
                    const bf16x8 vf = (bf16x8){lo[0], lo[1], lo[2], lo[3], hh[0], hh[1], hh[2], hh[3]};
                    o[2 + (i >> 2)] = __builtin_amdgcn_mfma_f32_32x32x16_bf16(vf, __builtin_bit_cast(bf16x8, pw[i & 3]), o[2 + (i >> 2)], 0, 0, 0); }
            }
        }
        ATT_DMA_WAIT();
        __syncthreads();
    }
    { auto rr = __builtin_amdgcn_permlane32_swap(__float_as_uint(l), __float_as_uint(l), false, false); l = __uint_as_float(rr[0]) + __uint_as_float(rr[1]); }
    l_run = l;
#undef ATT_DMA
#undef ATT_DMA_WAIT
}
__device__ __forceinline__ void store_gated(const f32x16 (&o)[2], float inv, const u32x4 (&gpre)[4], bf16_t* orow, int hi) {
#pragma unroll
    for (int dh = 0; dh < 2; ++dh)
#pragma unroll
        for (int jp = 0; jp < 2; ++jp) {
            const int cb = 32 * dh + 16 * jp + 8 * hi;
            const u32x4 L = gpre[dh * 2 + jp];
            const auto g0 = __builtin_amdgcn_permlane32_swap(L.x, L.z, false, false), g1 = __builtin_amdgcn_permlane32_swap(L.y, L.w, false, false);
            u32x2 w[2];
#pragma unroll
            for (int q = 0; q < 2; ++q) { const int j = 2 * jp + q; const unsigned gx = q ? g0[1] : g0[0], gy = q ? g1[1] : g1[0];
                const float a0 = __uint_as_float(gx << 16), a1 = __uint_as_float(gx & 0xffff0000u), a2 = __uint_as_float(gy << 16), a3 = __uint_as_float(gy & 0xffff0000u);
                w[q].x = cvtpk(o[dh][4 * j] * inv * a0, o[dh][4 * j + 1] * inv * a1); w[q].y = cvtpk(o[dh][4 * j + 2] * inv * a2, o[dh][4 * j + 3] * inv * a3); }
            const auto s0 = __builtin_amdgcn_permlane32_swap(w[0].x, w[1].x, false, false), s1 = __builtin_amdgcn_permlane32_swap(w[0].y, w[1].y, false, false);
            *(u32x4*)(orow + cb) = (u32x4){s0[0], s1[0], s0[1], s1[1]};
        }
}
}
typedef unsigned short bf16;
typedef float f32x4 __attribute__((ext_vector_type(4)));
typedef float f32x16 __attribute__((ext_vector_type(16)));
typedef unsigned v4u __attribute__((ext_vector_type(4)));
typedef unsigned v2u __attribute__((ext_vector_type(2)));
#define LAS __attribute__((address_space(3)))
constexpr int NWAVES = 8, NTHR = 512;
constexpr int M = 16384, DM = 1024, SEQ = 4096;
constexpr int N0 = 4096, LDW0 = 4104, N1 = 3328;
constexpr size_t MiB = 1u << 20;
constexpr size_t WS_CTL = 0, WS_BT0 = 2 * MiB, WS_BTO0 = 10 * MiB, WS_BT1 = 12 * MiB, WS_BTO1 = 19 * MiB, WS_RS0 = 21 * MiB, WS_LF = 22 * MiB, WS_SSQ = 24 * MiB,
                 WS_XB = 32 * MiB, WS_Z = 64 * MiB, WS_MIX = 192 * MiB, WS_END = 224 * MiB;
constexpr int RING_BYTES = 131072, MISC_OFF = RING_BYTES, LDS_BYTES = RING_BYTES + 4096;
constexpr float LOG2E = 1.4426950408889634f;
constexpr int CW_BAR = 4096;

__device__ __forceinline__ unsigned f2bf(float f) { unsigned u = __builtin_bit_cast(unsigned, f); return (u + 0x7fffu + ((u >> 16) & 1u)) >> 16; }
__device__ __forceinline__ unsigned pk2(float lo, float hi) { return f2bf(lo) | (f2bf(hi) << 16); }
__device__ __forceinline__ float wave_sum(float v) {
#pragma unroll
    for (int o = 1; o < 64; o <<= 1) v += __shfl_xor(v, o);
    return v;
}
__device__ __forceinline__ void p0_transpose_item(const float* W, int ldw, int N, const float* gain, bool permute, int swa, int swb, bf16* WT, LAS float* scr, int item, int lane, bool nts = false) {
    const int nblk = N / 32, kb = item / nblk, nb = item % nblk, k0 = 64 * kb, n0 = 32 * nb;
    float wv[32];
#pragma unroll
    for (int i = 0; i < 32; ++i) { const int kk = 2 * i + (lane >> 5); wv[i] = __builtin_nontemporal_load(W + (size_t)(k0 + kk) * ldw + n0 + (lane & 31)); }
    const float gl = gain ? gain[k0 + lane] : 1.0f;
#pragma unroll
    for (int i = 0; i < 32; ++i) { const int kk = 2 * i + (lane >> 5); scr[kk * 33 + (lane & 31)] = wv[i] * __shfl(gl, kk); }
    asm volatile("s_waitcnt lgkmcnt(0)" ::: "memory");
    const int c = lane & 7;
#pragma unroll
    for (int j = 0; j < 4; ++j) { const int n = (lane >> 3) + 8 * j; const LAS float* s = scr + (8 * c) * 33 + n;
        v4u o; o.x = pk2(s[0 * 33], s[1 * 33]); o.y = pk2(s[2 * 33], s[3 * 33]); o.z = pk2(s[4 * 33], s[5 * 33]); o.w = pk2(s[6 * 33], s[7 * 33]);
        int nl = n0 + n;
        if (permute) { int tile = nl >> 8; tile = (tile == swa) ? swb : (tile == swb ? swa : tile);
            const int t = nl & 255; nl = (tile << 8) | (((t >> 5) & 1) << 7) | (((t >> 6) & 3) << 5) | (t & 31); }
        if (nts) __builtin_nontemporal_store(o, (v4u*)(WT + (size_t)nl * 1024 + k0 + 8 * c)); else *(v4u*)(WT + (size_t)nl * 1024 + k0 + 8 * c) = o; }
    asm volatile("s_waitcnt lgkmcnt(0)" ::: "memory");
}

struct Params { const float* in[23]; float* out; unsigned char* ws; int ph_lo, ph_hi; };

__device__ __forceinline__ void p0_prologue(const Params& P, LAS unsigned char* lds, int tid, int lane, int wave) {
    const int G = gridDim.x, gw = blockIdx.x * NWAVES + wave, NGW = G * NWAVES;
    unsigned char* ws = P.ws;
    LAS float* wf = (LAS float*)(lds + 98304);
    { float t0[16], t1[16];
#pragma unroll
      for (int u = 0; u < 16; ++u) { const int i = tid + NTHR * u, k = i >> 3, j = i & 7; t0[u] = P.in[1][k]; t1[u] = P.in[2][(size_t)k * LDW0 + N0 + j]; }
#pragma unroll
      for (int u = 0; u < 16; ++u) { const int i = tid + NTHR * u, k = i >> 3, j = i & 7; wf[j * 1024 + k] = t0[u] * t1[u]; } }
    LAS float* scr = (LAS float*)(lds + wave * 8704);
    constexpr int I0 = 16 * (N0 / 32);
    for (int it = gw; it < I0; it += NGW) p0_transpose_item(P.in[2], LDW0, N0, P.in[1], true, -1, -1, (bf16*)(ws + WS_BT0), scr, it, lane);
    __syncthreads();
    const float* x = P.in[0]; bf16* xb = (bf16*)(ws + WS_XB); float* rs0 = (float*)(ws + WS_RS0); float* lf = (float*)(ws + WS_LF);
    f32x4 vn[4];
    if (gw < M) { const f32x4* xr = (const f32x4*)(x + (size_t)gw * DM) + lane;
#pragma unroll
        for (int j = 0; j < 4; ++j) vn[j] = __builtin_nontemporal_load(xr + 64 * j); }
    for (int mrow = gw; mrow < M; mrow += NGW) {
        f32x4 v[4];
#pragma unroll
        for (int j = 0; j < 4; ++j) v[j] = vn[j];
        if (mrow + NGW < M) { const f32x4* xr = (const f32x4*)(x + (size_t)(mrow + NGW) * DM) + lane;
#pragma unroll
            for (int j = 0; j < 4; ++j) vn[j] = __builtin_nontemporal_load(xr + 64 * j); }
        float s = 0.f; float dj[8];
#pragma unroll
        for (int j = 0; j < 8; ++j) dj[j] = 0.f;
#pragma unroll
        for (int j = 0; j < 4; ++j) { s += (v[j][0] * v[j][0] + v[j][1] * v[j][1]) + (v[j][2] * v[j][2] + v[j][3] * v[j][3]);
#pragma unroll
            for (int jj = 0; jj < 8; ++jj) { const f32x4 w = *(const LAS f32x4*)(wf + jj * 1024 + 4 * (lane + 64 * j));
                dj[jj] += (v[j][0] * w[0] + v[j][1] * w[1]) + (v[j][2] * w[2] + v[j][3] * w[3]); } }
        const float rstd = 1.0f / sqrtf(wave_sum(s) * (1.0f / DM) + 1e-6f);
        float r4[4], r2[2], r1;
#pragma unroll
        for (int i = 0; i < 4; ++i) { const float keep = (lane & 1) ? dj[4 + i] : dj[i], send = (lane & 1) ? dj[i] : dj[4 + i]; r4[i] = keep + __shfl_xor(send, 1); }
#pragma unroll
        for (int i = 0; i < 2; ++i) { const float keep = (lane & 2) ? r4[2 + i] : r4[i], send = (lane & 2) ? r4[i] : r4[2 + i]; r2[i] = keep + __shfl_xor(send, 2); }
        { const float keep = (lane & 4) ? r2[1] : r2[0], send = (lane & 4) ? r2[0] : r2[1]; r1 = keep + __shfl_xor(send, 4); }
        r1 += __shfl_xor(r1, 8); r1 += __shfl_xor(r1, 16); r1 += __shfl_xor(r1, 32);
        const int jo = 4 * (lane & 1) + 2 * ((lane >> 1) & 1) + ((lane >> 2) & 1);
        v2u* o8 = (v2u*)(xb + (size_t)mrow * DM) + lane;
#pragma unroll
        for (int j = 0; j < 4; ++j) { v2u w; w.x = pk2(v[j][0], v[j][1]); w.y = pk2(v[j][2], v[j][3]); o8[64 * j] = w; }
        if (lane == 0) rs0[mrow] = rstd;
        if (lane < 8) { const float z = r1 * rstd + P.in[13][jo]; const float ls = fminf(z, 0.f) - log1pf(expf(-fabsf(z)));
            const int b = mrow >> 12, sidx = mrow & 4095; lf[(size_t)(b * 8 + jo) * SEQ + sidx] = ls; }
    }
    if (wave == 0 && blockIdx.x == 8 % gridDim.x) {
        const float a = wave_sum(P.in[6][lane] * P.in[7][lane]), b = wave_sum(P.in[8][lane] * P.in[9][lane]);
        float ga = fabsf(P.in[4][lane] * P.in[5][lane]), gb = fabsf(P.in[11][lane] * P.in[12][lane]), gc = fabsf(P.in[17][lane] * P.in[18][lane]);
#pragma unroll
        for (int o = 1; o < 64; o <<= 1) { ga = fmaxf(ga, __shfl_xor(ga, o)); gb = fmaxf(gb, __shfl_xor(gb, o)); gc = fmaxf(gc, __shfl_xor(gc, o)); }
        if (lane == 0) { float* ctl = (float*)(ws + WS_CTL); ctl[0] = expf(a) - expf(b) + 0.2f;
            ctl[1] = 8.0f * ga * LOG2E * 1.02f + 0.25f; ctl[2] = 8.0f * gb * LOG2E * 1.02f + 0.25f; ctl[3] = 8.0f * gc * LOG2E * 1.02f + 0.25f; }
    }
    if (wave == 0) {
        for (int hh = blockIdx.x; hh < 8; hh += gridDim.x) {
            float gd = fabsf(P.in[20][lane] * P.in[21][lane]), t = -INFINITY;
            for (int i = lane; i < 320; i += 64) t = fmaxf(t, P.in[22][hh * 320 + i]);
#pragma unroll
            for (int o = 1; o < 64; o <<= 1) { gd = fmaxf(gd, __shfl_xor(gd, o)); t = fmaxf(t, __shfl_xor(t, o)); }
            if (lane == 0) ((float*)(ws + WS_CTL))[8 + hh] = 8.0f * gd * LOG2E * 1.02f + 0.25f + t * LOG2E;
        }
    }
}
constexpr int LATE_W_ITEMS = (16 * (DM / 32) + 16 * (N1 / 32) + 16 * (DM / 32)) / 8;
__device__ __forceinline__ void late_weight_item(const Params& P, LAS unsigned char* lds, int bitem, int lane, int wave) {
    constexpr int IO = 16 * (DM / 32), I1 = 16 * (N1 / 32);
    LAS float* scr = (LAS float*)(lds + wave * 8704);
    int r = bitem * 8 + wave;
    if (r < IO) p0_transpose_item(P.in[3], DM, DM, nullptr, false, -1, -1, (bf16*)(P.ws + WS_BTO0), scr, r, lane, true);
    else if (r < IO + I1) p0_transpose_item(P.in[15], N1, N1, P.in[14], true, 4, 12, (bf16*)(P.ws + WS_BT1), scr, r - IO, lane, true);
    else p0_transpose_item(P.in[16], DM, DM, nullptr, false, -1, -1, (bf16*)(P.ws + WS_BTO1), scr, r - IO - I1, lane, true);
    __syncthreads();
}
#define XB_TMO      128
#define XB_XCNT(j)  (256  + 64 * (j))
#define XB_XSUB(j)  (1280 + 64 * (j))
#define XB_XGEN(j)  (2304 + 64 * (j))
#define XB_TOP      3328
#define XB_TOPGEN   3392
#define XCD_BAR_WORDS 3456
#define XB_SPIN_CAP (1u << 18)

__device__ __forceinline__ unsigned xb_ld(unsigned* p)              { return __hip_atomic_load(p, __ATOMIC_RELAXED, __HIP_MEMORY_SCOPE_AGENT); }
__device__ __forceinline__ unsigned xb_add(unsigned* p, unsigned v) { return __hip_atomic_fetch_add(p, v, __ATOMIC_RELAXED, __HIP_MEMORY_SCOPE_AGENT); }
__device__ __forceinline__ unsigned xb_xcc_id() { return (unsigned)__builtin_amdgcn_s_getreg((3 << 11) | 20) & 0xFu; }
#define XB_SPIN(cond, bar) do { unsigned _sp = 0; while (cond) { __builtin_amdgcn_s_sleep(1); \
    if ((++_sp & 255u) == 0u) { if (xb_ld(&(bar)[XB_TMO])) break; if (_sp > XB_SPIN_CAP) { atomicAdd(&(bar)[XB_TMO], 1u); break; } } } } while (0)

struct XcdBarrier {
    unsigned* bar; unsigned x;
    volatile LAS unsigned* st;
};

__device__ __forceinline__ XcdBarrier xcd_barrier_post(unsigned* bar, volatile LAS unsigned* st) {
    XcdBarrier b; b.bar = bar; b.x = xb_xcc_id(); b.st = st;
    if (threadIdx.x == 0) (void)xb_add(&bar[XB_XCNT(b.x)], 1u);
    return b;
}
__device__ __forceinline__ void xcd_barrier_complete(unsigned* bar, unsigned x, unsigned& nloc, unsigned& nx) {
    const unsigned G = gridDim.x * gridDim.y * gridDim.z;
    unsigned sum, cnt, mine, sp = 0u;
    for (;;) {
        sum = 0u; cnt = 0u; mine = 0u;
#pragma unroll
        for (unsigned j = 0; j < 16; ++j) { const unsigned c = xb_ld(&bar[XB_XCNT(j)]); sum += c; cnt += (c > 0u) ? 1u : 0u; mine = (j == x) ? c : mine; }
        if (sum == G) break;
        __builtin_amdgcn_s_sleep(1);
        if ((++sp & 255u) == 0u) { if (xb_ld(&bar[XB_TMO])) break; if (sp > XB_SPIN_CAP) { atomicAdd(&bar[XB_TMO], 1u); break; } }
    }
    nloc = mine > 0u ? mine : 1u; nx = cnt > 0u ? cnt : 1u;
}

__device__ __forceinline__ void xcd_barrier(const XcdBarrier& b) {
    asm volatile("s_waitcnt vmcnt(0)" ::: "memory");
    __syncthreads();
    if (threadIdx.x == 0) {
        unsigned* bar = b.bar;
        __builtin_amdgcn_s_waitcnt(0);
        unsigned nloc = b.st[0], nx = b.st[1];
        if (nloc == 0u) { xcd_barrier_complete(bar, b.x, nloc, nx); b.st[0] = nloc; b.st[1] = nx; }
        const unsigned old = xb_add(&bar[XB_XSUB(b.x)], 1u);
        const unsigned gen = old / nloc;
        if (old + 1u == (gen + 1u) * nloc) {
            __builtin_amdgcn_fence(__ATOMIC_RELEASE, "agent");
            asm volatile("s_waitcnt vmcnt(0)" ::: "memory");
            const unsigned og = xb_add(&bar[XB_TOP], 1u);
            const unsigned tg = og / nx;
            if (og + 1u == (tg + 1u) * nx) xb_add(&bar[XB_TOPGEN], 1u);
            else XB_SPIN(xb_ld(&bar[XB_TOPGEN]) == tg, bar);
            __builtin_amdgcn_fence(__ATOMIC_ACQUIRE, "agent");
            xb_add(&bar[XB_XGEN(b.x)], 1u);
            asm volatile("s_waitcnt vmcnt(0)" ::: "memory");
        } else {
            XB_SPIN(xb_ld(&bar[XB_XGEN(b.x)]) == gen, bar);
            __builtin_amdgcn_fence(__ATOMIC_ACQUIRE, "agent");
            asm volatile("s_waitcnt vmcnt(0)" ::: "memory");
        }
    }
    __syncthreads();
}

__device__ __forceinline__ void unit_A(const Params& P, LAS unsigned char* lds, int bh, int qa, int tid, int lane, int wave) {
    const int b = bh >> 2, h = bh & 3, r32 = lane & 31, hi = lane >> 5;
    const bf16* Zb = (const bf16*)(P.ws + WS_Z) + (size_t)b * SEQ * N0;
    const int c = wave >> 2, j = wave & 3, q0w = 128 * qa + 32 * j, chunk = 2 * qa + (j >> 1);
    const float slope = exp2f(-2.0f * (float)(h + 1));
    const float thr = 150.0f / (slope * LOG2E);
    const int t_lo = max(0, (int)ceilf(((float)(128 * qa) - thr - 63.0f) * (1.0f / 64.0f))), w_lo = max(0, (int)ceilf(((float)q0w - thr - 63.0f) * (1.0f / 64.0f)));
    f32x16 o[4]; float l; att::u32x4 gdum[4];
    att::attn_core<2, 2, 0>(lds, Zb, N0, h * 128 + c * 64, 512 + h * 128, 512 + h * 128 + 64, 1024 + h * 128, q0w, t_lo, 2 * qa + 1, w_lo, chunk, c, -slope * LOG2E, -1, o, ((const float*)(P.ws + WS_CTL))[1], l, -1, gdum);
    const float inv = 1.0f / l;
    LAS f32x4* xs = (LAS f32x4*)lds + j * 1024 + lane;
    if (c == 1) {
#pragma unroll
        for (int i = 0; i < 4; ++i)
#pragma unroll
            for (int r4 = 0; r4 < 4; ++r4) xs[(i * 4 + r4) * 64] = (f32x4){o[i][4 * r4] * inv, o[i][4 * r4 + 1] * inv, o[i][4 * r4 + 2] * inv, o[i][4 * r4 + 3] * inv};
    }
    __syncthreads();
    if (c == 0) {
        const float lam = ((const float*)(P.ws + WS_CTL))[0];
        float ss = 0.f;
#pragma unroll
        for (int i = 0; i < 4; ++i)
#pragma unroll
            for (int r4 = 0; r4 < 4; ++r4) { const f32x4 x1 = xs[(i * 4 + r4) * 64];
#pragma unroll
                for (int e = 0; e < 4; ++e) { const float v = o[i][4 * r4 + e] * inv - lam * x1[e]; o[i][4 * r4 + e] = v; ss += v * v; } }
        ss += __shfl_xor(ss, 32);
        const float rn = 0.8f / sqrtf(ss * (1.0f / 128.0f) + 1e-6f);
        const size_t row = (size_t)b * SEQ + q0w + r32;
        const bf16* grow = (const bf16*)(P.ws + WS_Z) + row * N0 + 1536 + h * 128;
        bf16* orow = (bf16*)(P.ws + WS_MIX) + row * DM + h * 128;
        const float* sg = P.in[10];
#pragma unroll
        for (int i = 0; i < 4; ++i)
#pragma unroll
            for (int jp = 0; jp < 2; ++jp) {
                const int cb = 32 * i + 16 * jp + 8 * hi;
                const v4u L = *(const v4u*)(grow + cb);
                const auto g0 = __builtin_amdgcn_permlane32_swap(L.x, L.z, false, false), g1 = __builtin_amdgcn_permlane32_swap(L.y, L.w, false, false);
                v2u w[2];
#pragma unroll
                for (int q = 0; q < 2; ++q) { const int jj = 2 * jp + q, d = 32 * i + 8 * jj + 4 * hi; const unsigned gx = q ? g0[1] : g0[0], gy = q ? g1[1] : g1[0];
                    const f32x4 s4 = *(const f32x4*)(sg + d);
                    const float a0 = __uint_as_float(gx << 16), a1 = __uint_as_float(gx & 0xffff0000u), a2 = __uint_as_float(gy << 16), a3 = __uint_as_float(gy & 0xffff0000u);
                    w[q].x = att::cvtpk(o[i][4 * jj] * rn * s4[0] * a0, o[i][4 * jj + 1] * rn * s4[1] * a1); w[q].y = att::cvtpk(o[i][4 * jj + 2] * rn * s4[2] * a2, o[i][4 * jj + 3] * rn * s4[3] * a3); }
                const auto s0 = __builtin_amdgcn_permlane32_swap(w[0].x, w[1].x, false, false), s1 = __builtin_amdgcn_permlane32_swap(w[0].y, w[1].y, false, false);
                *(v4u*)(orow + cb) = (v4u){s0[0], s1[0], s0[1], s1[1]};
            }
    }
    __syncthreads();
}
__device__ __forceinline__ void unit_B(const Params& P, LAS unsigned char* lds, int bh, int qb, int tid, int lane, int wave) {
    const int b = bh >> 3, h = bh & 7, r32 = lane & 31, hi = lane >> 5;
    const bf16* Zb = (const bf16*)(P.ws + WS_Z) + (size_t)b * SEQ * N0;
    const int q0w = 256 * qb + 32 * wave, chunk = 4 * qb + (wave >> 1);
    {
        const float* lfs = (const float*)(P.ws + WS_LF) + (size_t)bh * SEQ;
        LAS float* cl = (LAS float*)(lds + att::LDS_CUM);
        LAS float* part = (LAS float*)(lds + MISC_OFF + 256);
        const int n = 256 * (qb + 1); const bool mine = tid * 8 < n;
        f32x4 a4 = (f32x4){0.f, 0.f, 0.f, 0.f}, b4 = a4;
        if (mine) { const f32x4* src = (const f32x4*)(lfs + tid * 8); a4 = src[0]; b4 = src[1]; }
        float v0 = a4[0], v1 = v0 + a4[1], v2 = v1 + a4[2], v3 = v2 + a4[3], v4 = v3 + b4[0], v5 = v4 + b4[1], v6 = v5 + b4[2], v7 = v6 + b4[3];
        float inc = v7;
#pragma unroll
        for (int o_ = 1; o_ < 64; o_ <<= 1) { const float t_ = __shfl_up(inc, o_); if (lane >= o_) inc += t_; }
        if (lane == 63) part[wave] = inc;
        __syncthreads();
        float base = inc - v7;
#pragma unroll
        for (int w_ = 0; w_ < 8; ++w_) if (w_ < wave) base += part[w_];
        if (tid == 32 * qb) part[8] = v0 + base;
        __syncthreads();
        const float cref = part[8];
        if (mine) { LAS f32x4* dst = (LAS f32x4*)(cl + tid * 8);
            dst[0] = (f32x4){(cref - (v0 + base)) * LOG2E, (cref - (v1 + base)) * LOG2E, (cref - (v2 + base)) * LOG2E, (cref - (v3 + base)) * LOG2E};
            dst[1] = (f32x4){(cref - (v4 + base)) * LOG2E, (cref - (v5 + base)) * LOG2E, (cref - (v6 + base)) * LOG2E, (cref - (v7 + base)) * LOG2E}; }
    }
    __syncthreads();
    const float mrow = ((const float*)(P.ws + WS_CTL))[2] + ((const LAS float*)(lds + att::LDS_CUM))[q0w + r32];
    int t_lo, w_lo;
    { const LAS float* cl = (const LAS float*)(lds + att::LDS_CUM); const int ti = lane <= 4 * qb + 3 ? lane : 4 * qb + 3; const float ce = cl[64 * ti + 63];
      const unsigned long long kw = __ballot(ce - cl[q0w] >= -150.0f), kb = __ballot(ce - cl[256 * qb] >= -150.0f);
      w_lo = kw ? (int)__builtin_ctzll(kw) : chunk; t_lo = kb ? (int)__builtin_ctzll(kb) : 4 * qb; if (w_lo > chunk) w_lo = chunk; }
    t_lo = __builtin_amdgcn_readfirstlane(t_lo); w_lo = __builtin_amdgcn_readfirstlane(w_lo);
    f32x16 o[2]; float l; att::u32x4 gpre[4];
    att::attn_core<1, 1, 1>(lds, Zb, N0, 2048 + h * 64, 2560 + h * 64, 0, 3072 + h * 64, q0w, t_lo, 4 * qb + 3, w_lo, chunk, 0, 0.f, chunk, o, mrow, l, 3584 + h * 64, gpre);
    const size_t row = (size_t)b * SEQ + q0w + r32;
    att::store_gated(o, 1.0f / l, gpre, (bf16*)(P.ws + WS_MIX) + row * DM + 512 + h * 64, hi);
}
__device__ __forceinline__ void unit_C(const Params& P, LAS unsigned char* lds, int b, int kvh, int c, int tid, int lane, int wave) {
    const int r32 = lane & 31, hi = lane >> 5, h = kvh * 4 + (wave >> 1);
    const bf16* Zb = (const bf16*)(P.ws + WS_Z) + (size_t)b * SEQ * N1;
    const int q0w = 64 * c + 32 * (wave & 1);
    const int t_lo = (c - 2) > 0 ? c - 2 : 0;
    const float slope = exp2f(-(float)(h + 1));
    const float m = ((const float*)(P.ws + WS_CTL))[3];
    f32x16 o[2]; float l; att::u32x4 gpre[4];
    att::attn_core<1, 1, 2>(lds, Zb, N1, h * 64, 512 + kvh * 64, 0, 640 + kvh * 64, q0w, t_lo, c, t_lo, c, 0, -slope * LOG2E, -1, o, m, l, 768 + h * 64, gpre);
    l += exp2f(P.in[19][h] * LOG2E - m);
    const size_t row = (size_t)b * SEQ + q0w + r32;
    att::store_gated(o, 1.0f / l, gpre, (bf16*)(P.ws + WS_MIX) + row * DM + h * 64, hi);
}
__device__ __forceinline__ void unit_D(const Params& P, LAS unsigned char* lds, int bh, int qb, int tid, int lane, int wave) {
    const int b = bh >> 3, h = bh & 7, r32 = lane & 31, hi = lane >> 5;
    const bf16* Zb = (const bf16*)(P.ws + WS_Z) + (size_t)b * SEQ * N1;
    const int q0w = 256 * qb + 32 * wave, chunk = 4 * qb + (wave >> 1);
    const int t_lo = (4 * qb - 8) > 0 ? 4 * qb - 8 : 0, w_lo = (chunk - 8) > 0 ? chunk - 8 : 0;
    { LAS float* tb = (LAS float*)(lds + att::LDS_TAB); const float* rt = P.in[22] + h * 320;
      const float mh = ((const float*)(P.ws + WS_CTL))[8 + h];
      for (int i = tid; i < 640; i += NTHR) { const int e = 638 - i; tb[i] = rt[e < 319 ? (e < 0 ? 0 : e) : 319] * LOG2E - mh; } }
    const float m = ((const float*)(P.ws + WS_CTL))[8 + h];
    f32x16 o[2]; float l; att::u32x4 gpre[4];
    att::attn_core<1, 1, 3>(lds, Zb, N1, 1280 + h * 64, 1792 + h * 64, 0, 2304 + h * 64, q0w, t_lo, 4 * qb + 3, w_lo, chunk, 0, 0.f, -1, o, m, l, 2816 + h * 64, gpre);
    const size_t row = (size_t)b * SEQ + q0w + r32;
    att::store_gated(o, 1.0f / l, gpre, (bf16*)(P.ws + WS_MIX) + row * DM + 512 + h * 64, hi);
}
__device__ __forceinline__ int queue_next(unsigned* ctr, LAS unsigned char* lds, int tid) {
    volatile LAS int* w = (volatile LAS int*)(lds + MISC_OFF);
    if (tid == 0) w[0] = (int)atomicAdd(ctr, 1u);
    __syncthreads();
    const int it = w[0];
    __syncthreads();
    return it;
}

__global__ void __launch_bounds__(NTHR, 2) trunk_fwd(Params P) {
    extern __shared__ __attribute__((aligned(16))) unsigned char lds_raw[];
    LAS unsigned char* lds = (LAS unsigned char*)lds_raw;
    const int tid = threadIdx.x, lane = tid & 63, wave = __builtin_amdgcn_readfirstlane(tid >> 6);
    const int lo = P.ph_lo, hi_ = P.ph_hi, G = gridDim.x;
    unsigned char* ws = P.ws;
#define IN(k) (lo <= (k) && (k) < hi_)
    { volatile LAS unsigned* mz = (volatile LAS unsigned*)(lds + MISC_OFF); if (tid < 64) mz[tid] = 0u; }
    __syncthreads();
    XcdBarrier bar = xcd_barrier_post((unsigned*)(ws + WS_CTL) + CW_BAR, (volatile LAS unsigned*)(lds + MISC_OFF + 64));
    if (P.ph_hi > 1000) cg::this_grid().sync();
#define SEAM(k) do { if (IN(k) && IN((k) + 1)) { xcd_barrier(bar); } } while (0)
    if (IN(0)) { p0_prologue(P, lds, tid, lane, wave); __syncthreads();
#if PROBE_REP0
        p0_prologue(P, lds, tid, lane, wave); __syncthreads();
#endif
    }
    SEAM(0);
    if (IN(1)) {
        pg8::Gemm g{(const bf16*)(ws + WS_XB), (const bf16*)(ws + WS_BT0), M, N0, DM}; pg8::StaticOrder S; S.init(M, N0, G, (int)blockIdx.x);
        pg8::EpiIn E{(bf16*)(ws + WS_Z), N0, (const float*)(ws + WS_RS0), nullptr,
                     {8, 16, 24, 32, 40, 48, 56, 64}, {1, 2, 0, 3, 1, 2, 0, 3}, {P.in[4], P.in[5], nullptr, nullptr, P.in[11], P.in[12], nullptr, nullptr}, 0, -1, -1};
        pg8::gemm_phase<pg8::EpiIn, pg8::StaticOrder, PG8_ALIGN, PG8_SP2>(lds, g, S, E);
        __syncthreads();
#if PROBE_REP1
        pg8::gemm_phase<pg8::EpiIn, pg8::StaticOrder, PG8_ALIGN, PG8_SP2>(lds, g, S, E);
        __syncthreads();
#endif
    }
    SEAM(1);
    if (IN(2)) {
        unsigned* ctr = (unsigned*)(ws + WS_CTL) + 64;
        int it = (int)blockIdx.x;
        for (;;) {
            if (it >= 1024) break;
            const int pp = it >> 6, r = it & 63;
            if (r < 16) unit_A(P, lds, r, 31 - 2 * pp, tid, lane, wave);
            else if (r < 48) unit_B(P, lds, r - 16, 15 - pp, tid, lane, wave);
            else unit_A(P, lds, r - 48, 30 - 2 * pp, tid, lane, wave);
            it = G + queue_next(ctr, lds, tid);
        }
        while (it < 1024 + LATE_W_ITEMS) { late_weight_item(P, lds, it - 1024, lane, wave); it = G + queue_next(ctr, lds, tid); }
    }
    SEAM(2);
    if (IN(3)) {
        pg8::Gemm g{(const bf16*)(ws + WS_MIX), (const bf16*)(ws + WS_BTO0), M, DM, DM}; pg8::StaticOrder S; S.init(M, DM, G, (int)blockIdx.x);
        pg8::EpiOut E{P.in[0], nullptr, nullptr, (bf16*)(ws + WS_XB), (float*)(ws + WS_SSQ)};
        pg8::gemm_phase<pg8::EpiOut, pg8::StaticOrder, false, PG8_SP2>(lds, g, S, E);
        __syncthreads();
#if PROBE_REP3
        pg8::gemm_phase<pg8::EpiOut, pg8::StaticOrder, false, PG8_SP2>(lds, g, S, E);
        __syncthreads();
#endif
    }
    SEAM(3);
    if (IN(4)) {
        pg8::Gemm g{(const bf16*)(ws + WS_XB), (const bf16*)(ws + WS_BT1), M, 3072, DM}; pg8::StaticOrder S; S.init(M, 3072, G, (int)blockIdx.x);
        pg8::EpiIn E{(bf16*)(ws + WS_Z), N1, nullptr, (const float*)(ws + WS_SSQ),
                     {8, 10, 12, 20, 28, 36, 44, 52}, {1, 2, 0, 3, 1, 2, 0, 3}, {P.in[17], P.in[18], nullptr, nullptr, P.in[20], P.in[21], nullptr, nullptr}, 0, 4, 12};
        pg8::gemm_phase<pg8::EpiIn, pg8::StaticOrder, PG8_ALIGN, PG8_SP2>(lds, g, S, E);
        __syncthreads();
    }
    SEAM(4);
    if (IN(5)) {
        unsigned* late = (unsigned*)(ws + WS_CTL) + 320;
        {
            pg8::Gemm g2{(const bf16*)(ws + WS_XB), (const bf16*)(ws + WS_BT1) + (size_t)3072 * 1024, M, 256, DM}; pg8::StaticOrder S2; S2.init(M, 256, G, (int)blockIdx.x);
            pg8::Unit u0; int n_mine = 0; while (S2.next(n_mine, u0)) ++n_mine;
            const bool mine = n_mine > 0;
            pg8::EpiIn E2{(bf16*)(ws + WS_Z), N1, nullptr, (const float*)(ws + WS_SSQ),
                          {8, 10, 12, 20, 28, 36, 44, 52}, {1, 2, 0, 3, 1, 2, 0, 3}, {P.in[17], P.in[18], nullptr, nullptr, P.in[20], P.in[21], nullptr, nullptr}, 12, 4, 12};
            pg8::gemm_phase<pg8::EpiIn, pg8::StaticOrder, PG8_ALIGN, PG8_SP2>(lds, g2, S2, E2);
            if (mine) {
                asm volatile("s_waitcnt vmcnt(0)" ::: "memory"); __syncthreads();
                if (tid == 0) { __builtin_amdgcn_fence(__ATOMIC_RELEASE, "agent"); asm volatile("s_waitcnt vmcnt(0)" ::: "memory"); (void)xb_add(late, (unsigned)n_mine); }
                __syncthreads();
            }
        }
        bool late_ok = false;
        for (int rep = 0; rep < 1 + PROBE_REP5; ++rep) {
        unsigned* ctr = (unsigned*)(ws + WS_CTL) + 128 + 128 * rep;
        const int NL = G < 64 ? G : 64; const bool owner = (int)blockIdx.x < NL;
#define P5_NEXT() ({ const int n_ = queue_next(ctr, lds, tid); n_ < NL ? n_ : n_ - NL + G; })
        for (int it = owner ? P5_NEXT() : (int)blockIdx.x; it < 1024; it = P5_NEXT()) {
            if (it < 512) { const int bh = it & 31, qb = 15 - (it >> 5); unit_D(P, lds, bh, qb, tid, lane, wave); }
            else {
                const int r = it - 512, half = r >> 8, idx = r & 255, cc = 63 - (idx >> 2), bb = idx & 3;
                if (half && !late_ok) {
                    if (tid == 0) { unsigned sp = 0; while (xb_ld(late) < 64u) { __builtin_amdgcn_s_sleep(2); if (++sp > (1u << 22)) break; }
                        __builtin_amdgcn_fence(__ATOMIC_ACQUIRE, "agent"); asm volatile("s_waitcnt vmcnt(0)" ::: "memory"); }
                    __syncthreads(); late_ok = true;
                }
                unit_C(P, lds, bb, half, cc, tid, lane, wave);
            }
        }
        }
    }
    SEAM(5);
    if (IN(6)) {
        pg8::Gemm g{(const bf16*)(ws + WS_MIX), (const bf16*)(ws + WS_BTO1), M, DM, DM}; pg8::StaticOrder S; S.init(M, DM, G, (int)blockIdx.x);
        pg8::EpiOut E{nullptr, (const bf16*)(ws + WS_XB), P.out, nullptr, nullptr};
        pg8::gemm_phase<pg8::EpiOut, pg8::StaticOrder, false, PG8_SP2>(lds, g, S, E);
    }
#undef IN
#undef SEAM
}

extern "C" void kernel_launch(void* const* d_in, const int* in_sizes, int n_in, void* d_out, int out_size, void* d_ws, size_t ws_size, hipStream_t stream) {
    static int grid = 0;
    if (grid == 0) {
        if (n_in != 23 || out_size != M * DM || ws_size < WS_END) { fprintf(stderr, "kernel_launch: unexpected shapes (n_in %d, out %d, ws %zu)\n", n_in, out_size, ws_size); grid = -1; return; }
        int dev = 0, cus = 0, per_cu = 0;
        hipGetDevice(&dev); hipDeviceGetAttribute(&cus, hipDeviceAttributeMultiprocessorCount, dev);
        if (hipFuncSetAttribute((const void*)trunk_fwd, hipFuncAttributeMaxDynamicSharedMemorySize, LDS_BYTES) != hipSuccess) { fprintf(stderr, "kernel_launch: hipFuncSetAttribute failed\n"); grid = -1; return; }
        if (hipOccupancyMaxActiveBlocksPerMultiprocessor(&per_cu, (const void*)trunk_fwd, NTHR, LDS_BYTES) != hipSuccess || per_cu < 1) { fprintf(stderr, "kernel_launch: occupancy query says %d\n", per_cu); per_cu = 1; }
        (void)hipGetLastError();
        grid = cus * 1;
        if (grid <= 0) grid = 256;
    }
    if (grid < 0) return;
    if (hipMemsetAsync((char*)d_ws + WS_CTL, 0, 65536, stream) != hipSuccess) { fprintf(stderr, "kernel_launch: memset failed\n"); return; }
    Params p{};
    for (int i = 0; i < 23; ++i) p.in[i] = (const float*)d_in[i];
    p.out = (float*)d_out; p.ws = (unsigned char*)d_ws;
#if MK_LAUNCHES == 1
    p.ph_lo = 0; p.ph_hi = 7;
    void* args[] = {&p};
    hipError_t e = hipLaunchCooperativeKernel((const void*)trunk_fwd, dim3(grid), dim3(NTHR), args, LDS_BYTES, stream);
    if (e != hipSuccess) fprintf(stderr, "kernel_launch: cooperative launch failed: %s (grid %d)\n", hipGetErrorString(e), grid);
#else
    for (int ph = 0; ph < 7; ++ph) { p.ph_lo = ph; p.ph_hi = ph + 1; hipLaunchKernelGGL(trunk_fwd, dim3(grid), dim3(NTHR), LDS_BYTES, stream, p); }
#endif
}
```

```cpp
#include <hip/hip_runtime.h>
#include <hip/hip_cooperative_groups.h>
#include <cstdio>
#include <cstdint>
namespace cg = cooperative_groups;
#ifndef PROBE_REP0
#define PROBE_REP0 0
#endif
#ifndef PROBE_REP3
#define PROBE_REP3 0
#endif
#ifndef PROBE_REP4
#define PROBE_REP4 0
#endif
#ifndef PROBE_REP1
#define PROBE_REP1 0
#endif
#ifndef PROBE_REP2
#define PROBE_REP2 0
#endif
#ifndef PROBE_REP5
#define PROBE_REP5 0
#endif
#ifndef MK_LAUNCHES
#define MK_LAUNCHES 1
#endif
namespace pg8 {
#define PG8_LAS __attribute__((address_space(3)))
typedef unsigned short bf16_t;
typedef short bf16x8 __attribute__((ext_vector_type(8)));
typedef float f32x4 __attribute__((ext_vector_type(4)));
typedef unsigned u32x4 __attribute__((ext_vector_type(4)));
constexpr int BM = 256, BK = 64, HALF = 128, HTB = HALF * BK * 2  , STAGE_BYTES = 8 * HTB, NXCD = 8, WGM = 8;

__host__ __device__ __forceinline__ int lds_byte(int r, int c) { const int st = (r >> 4) * 2 + (c >> 5), rr = r & 15, cc = c & 31, ob = rr * 64 + cc * 2; return st * 1024 + (ob ^ (((ob >> 9) & 1) << 5)); }
__host__ __device__ __forceinline__ void stage_rc(int b, int& R, int& C) { const int st = b / 1024, sb = b % 1024, swz = sb ^ (((sb >> 9) & 1) << 5); R = (st >> 1) * 16 + swz / 64; C = (st & 1) * 32 + (swz % 64) / 2; }
__host__ __device__ __forceinline__ int perm32(int rho) { const int n = rho >> 4, i = rho & 15; return 8 * (i >> 2) + 4 * n + (i & 3); }

struct Unit { int pm, pn; };
struct Gemm { const bf16_t* A; const bf16_t* Bt; int M, N, K; };

struct StaticOrder {
    int nM, nN, nwg, G, c;
    __host__ __device__ void init(int M, int N, int G_, int c_) { nM = M / BM; nN = N / BM; nwg = nM * nN; G = G_; c = c_; }
    __host__ __device__ bool next(int i, Unit& u) const {
        const long L = (long)i * G + c; if (L >= nwg) return false;
        int wgid = (int)L; { const int q = nwg / NXCD, r = nwg % NXCD, xcd = wgid % NXCD, off = wgid / NXCD; wgid = (xcd < r ? xcd * (q + 1) : r * (q + 1) + (xcd - r) * q) + off; }
        const int nig = WGM * nN, gid = wgid / nig, fm = gid * WGM, gsz = (nM - fm) < WGM ? (nM - fm) : WGM;
        u.pm = fm + ((wgid % nig) % gsz); u.pn = (wgid % nig) / gsz; return true;
    }
    __device__ __forceinline__ void a_ready(const Unit&) const {}
    __device__ __forceinline__ void done(const Unit&) const {}
};

__device__ __forceinline__ unsigned cvt_pk_bf16(float lo, float hi) { unsigned r; asm volatile("v_cvt_pk_bf16_f32 %0, %1, %2" : "=v"(r) : "v"(lo), "v"(hi)); return r; }
typedef float f32x2 __attribute__((ext_vector_type(2)));
typedef unsigned u32x2 __attribute__((ext_vector_type(2)));
constexpr float QK_C2 = 0.125f * 1.4426950408889634f;
struct EpiIn {
    static constexpr bool PERM = true, AFTER_DRAIN = false;
    bf16_t* O; int ldc; const float* rs; const float* ssq;
    int seg_end[8]; int seg_mode[8]; const float* seg_g[8];
    int pn_off, sw_a, sw_b;
    __device__ __forceinline__ void operator()(const f32x4 (&acc)[2][2][4][2], const Unit& u, int wr, int wc, int fr, int fq) const {
        int lt = u.pn + pn_off; lt = (lt == sw_a) ? sw_b : (lt == sw_b ? sw_a : lt);
        const int gidx = lt * 4 + wc;
        int mode = 0; const float* g = nullptr;
#pragma unroll
        for (int s = 7; s >= 0; --s) if (gidx < seg_end[s]) { mode = seg_mode[s]; g = seg_g[s]; }
        f32x4 gv[2][2];
#pragma unroll
        for (int bj = 0; bj < 2; ++bj)
#pragma unroll
            for (int n = 0; n < 2; ++n) gv[bj][n] = (mode == 1 || mode == 2) ? *(const f32x4*)(g + 32 * bj + 8 * fq + 4 * n) : (f32x4){1.f, 1.f, 1.f, 1.f};
        const float qs = (mode == 1) ? QK_C2 : 1.0f;
        float rr[2][4];
        if (rs) {
#pragma unroll
            for (int ai = 0; ai < 2; ++ai)
#pragma unroll
                for (int m = 0; m < 4; ++m) rr[ai][m] = rs[u.pm * BM + ai * HALF + wr * 64 + m * 16 + fr];
        }
        asm volatile("" ::: "memory");
#pragma unroll
        for (int ai = 0; ai < 2; ++ai) {
            if (!rs) {
                f32x4 sp[4][4];
#pragma unroll
                for (int m = 0; m < 4; ++m) { const f32x4* p_ = (const f32x4*)(ssq + (size_t)(u.pm * BM + ai * HALF + wr * 64 + m * 16 + fr) * 16);
#pragma unroll
                    for (int q = 0; q < 4; ++q) sp[m][q] = p_[q]; }
                asm volatile("" ::: "memory");
#pragma unroll
                for (int m = 0; m < 4; ++m) { const f32x4 a = sp[m][0], b = sp[m][1], c = sp[m][2], d = sp[m][3];
                    const float t = ((a[0] + a[1]) + (a[2] + a[3])) + ((b[0] + b[1]) + (b[2] + b[3])) + ((c[0] + c[1]) + (c[2] + c[3])) + ((d[0] + d[1]) + (d[2] + d[3]));
                    rr[ai][m] = __builtin_amdgcn_rsqf(t * (1.0f / 1024.0f) + 1e-6f); }
            }
#pragma unroll
            for (int m = 0; m < 4; ++m) {
                const int row = u.pm * BM + ai * HALF + wr * 64 + m * 16 + fr;
                const float r = rr[ai][m];
                f32x4 v[2][2];
#pragma unroll
                for (int bj = 0; bj < 2; ++bj)
#pragma unroll
                    for (int n = 0; n < 2; ++n) v[bj][n] = acc[ai][bj][m][n] * r;
                if (mode == 1 || mode == 2) {
                    float ss = 0.f;
#pragma unroll
                    for (int bj = 0; bj < 2; ++bj)
#pragma unroll
                        for (int n = 0; n < 2; ++n) { const f32x4 x = v[bj][n]; ss += (x[0] * x[0] + x[1] * x[1]) + (x[2] * x[2] + x[3] * x[3]); }
                    ss += __shfl_xor(ss, 16); ss += __shfl_xor(ss, 32);
                    const float rn = qs * __builtin_amdgcn_rsqf(ss * (1.0f / 64.0f) + 1e-6f);
#pragma unroll
                    for (int bj = 0; bj < 2; ++bj)
#pragma unroll
                        for (int n = 0; n < 2; ++n) v[bj][n] = v[bj][n] * rn * gv[bj][n];
                } else if (mode == 3) {
#pragma unroll
                    for (int bj = 0; bj < 2; ++bj)
#pragma unroll
                        for (int n = 0; n < 2; ++n)
#pragma unroll
                            for (int e = 0; e < 4; ++e) { const float x = v[bj][n][e]; v[bj][n][e] = x * __builtin_amdgcn_rcpf(1.0f + __builtin_amdgcn_exp2f(x * -1.4426950408889634f)); }
                }
                bf16_t* rowp = O + (size_t)row * ldc + lt * BM + wc * 64 + 8 * fq;
#pragma unroll
                for (int bj = 0; bj < 2; ++bj) { u32x4 w; w.x = cvt_pk_bf16(v[bj][0][0], v[bj][0][1]); w.y = cvt_pk_bf16(v[bj][0][2], v[bj][0][3]); w.z = cvt_pk_bf16(v[bj][1][0], v[bj][1][1]); w.w = cvt_pk_bf16(v[bj][1][2], v[bj][1][3]);
                    *(u32x4*)(rowp + bj * 32) = w; }
            }
        }
    }
};
struct EpiOut {
    static constexpr bool PERM = true, AFTER_DRAIN = false;
    const float* base; const bf16_t* base16; float* out; bf16_t* xb; float* ssq;
    __device__ __forceinline__ void operator()(const f32x4 (&acc)[2][2][4][2], const Unit& u, int wr, int wc, int fr, int fq) const {
        const int col0 = u.pn * BM + wc * 32 + 8 * fq;
#pragma unroll
        for (int ai = 0; ai < 2; ++ai) {
            f32x4 pre[4][2][2];
#pragma unroll
            for (int m = 0; m < 4; ++m) { const size_t off = (size_t)(u.pm * BM + ai * HALF + wr * 64 + m * 16 + fr) * 1024 + col0;
#pragma unroll
                for (int bj = 0; bj < 2; ++bj) {
                    if (base16) { const u32x4 w = *(const u32x4*)(base16 + off + bj * HALF);
                        pre[m][bj][0] = (f32x4){__uint_as_float(w.x << 16), __uint_as_float(w.x & 0xffff0000u), __uint_as_float(w.y << 16), __uint_as_float(w.y & 0xffff0000u)};
                        pre[m][bj][1] = (f32x4){__uint_as_float(w.z << 16), __uint_as_float(w.z & 0xffff0000u), __uint_as_float(w.w << 16), __uint_as_float(w.w & 0xffff0000u)}; }
                    else { pre[m][bj][0] = *(const f32x4*)(base + off + bj * HALF); pre[m][bj][1] = *(const f32x4*)(base + off + bj * HALF + 4); } } }
            asm volatile("" ::: "memory");
#pragma unroll
            for (int m = 0; m < 4; ++m) {
                const int row = u.pm * BM + ai * HALF + wr * 64 + m * 16 + fr;
                const size_t off = (size_t)row * 1024 + col0;
                float ss = 0.f;
#pragma unroll
                for (int bj = 0; bj < 2; ++bj) {
                    const f32x4 o0 = pre[m][bj][0] + acc[ai][bj][m][0], o1 = pre[m][bj][1] + acc[ai][bj][m][1];
                    if (out) { *(f32x4*)(out + off + bj * HALF) = o0; *(f32x4*)(out + off + bj * HALF + 4) = o1; }
                    ss += (o0[0] * o0[0] + o0[1] * o0[1]) + (o0[2] * o0[2] + o0[3] * o0[3]) + (o1[0] * o1[0] + o1[1] * o1[1]) + (o1[2] * o1[2] + o1[3] * o1[3]);
                    if (xb) { u32x4 w; w.x = cvt_pk_bf16(o0[0], o0[1]); w.y = cvt_pk_bf16(o0[2], o0[3]); w.z = cvt_pk_bf16(o1[0], o1[1]); w.w = cvt_pk_bf16(o1[2], o1[3]);
                        *(u32x4*)(xb + off + bj * HALF) = w; }
                }
                if (ssq) { ss += __shfl_xor(ss, 16); ss += __shfl_xor(ss, 32); if (fq == 0) ssq[(size_t)row * 16 + u.pn * 4 + wc] = ss; }
            }
            asm volatile("" ::: "memory");
        }
    }
};

template <class Epi, class Sched, bool ALIGN_EPI = false, bool SP2 = false>
__device__ __forceinline__ void gemm_phase(PG8_LAS unsigned char* lds, const Gemm g, const Sched& S, const Epi& E) {
    const int tid = threadIdx.x, wid = __builtin_amdgcn_readfirstlane(tid >> 6), lane = tid & 63, wr = wid >> 2, wc = wid & 3, fr = lane & 15, fq = lane >> 4;
    const int K = g.K, nt = K / BK;
    unsigned voffA[2], voffB[2];
#pragma unroll
    for (int i = 0; i < 2; ++i) { int R, C; stage_rc(tid * 16 + i * 8192, R, C); const int Rb = Epi::PERM ? ((R & ~31) + perm32(R & 31)) : R;
        voffA[i] = (unsigned)(R * K + C) * 2u; voffB[i] = (unsigned)(Rb * K + C) * 2u; }
    const size_t kstep = (size_t)(BK * 2);
    const size_t hstep = (size_t)HALF * K * 2;
    const size_t tstep = 2 * hstep;
    const unsigned ldsw = (unsigned)wid * 1024u;
    const int aoff = lds_byte(wr * 64 + fr, fq * 8), boff = lds_byte(wc * 32 + fr, fq * 8);
#define PG8_SA(b, h) (((b) * 2 + (h)) * HTB)
#define PG8_SB(b, h) ((4 + (b) * 2 + (h)) * HTB)
#define PG8_STAGE(bufoff, gbase, voff) do { _Pragma("unroll") for (int _i = 0; _i < 2; ++_i) \
        __builtin_amdgcn_global_load_lds((const unsigned*)((const char*)(gbase) + (voff)[_i]), (PG8_LAS unsigned*)(lds + (bufoff) + ldsw + _i * 8192), 16, 0, 0); } while (0)
#define PG8_LDA(dst, b, h) do { _Pragma("unroll") for (int m = 0; m < 4; ++m) _Pragma("unroll") for (int k = 0; k < 2; ++k) dst[m][k] = *(const PG8_LAS bf16x8*)(lds + PG8_SA(b, h) + aoff + m * 2048 + k * 1024); } while (0)
#define PG8_LDB(dst, b, h) do { _Pragma("unroll") for (int n = 0; n < 2; ++n) _Pragma("unroll") for (int k = 0; k < 2; ++k) dst[n][k] = *(const PG8_LAS bf16x8*)(lds + PG8_SB(b, h) + boff + n * 2048 + k * 1024); } while (0)
#define PG8_MMA(ai, bj, At, Bt) do { __builtin_amdgcn_s_setprio(1); _Pragma("unroll") for (int m = 0; m < 4; ++m) _Pragma("unroll") for (int n = 0; n < 2; ++n) _Pragma("unroll") for (int k = 0; k < 2; ++k) \
        acc[ai][bj][m][n] = __builtin_amdgcn_mfma_f32_16x16x32_bf16(Bt[n][k], At[m][k], acc[ai][bj][m][n], 0, 0, 0); __builtin_amdgcn_s_setprio(0); } while (0)
#define PG8_WAIT_V(n) asm volatile("s_waitcnt vmcnt(" #n ")" ::: "memory")
#define PG8_WAIT_L(n) asm volatile("s_waitcnt lgkmcnt(" #n ")" ::: "memory")
#define PG8_BAR __builtin_amdgcn_s_barrier()
#define PG8_SCHED __builtin_amdgcn_sched_barrier(0)
    Unit cur, nxt; int ui = 0;
    if (!S.next(0, cur)) return;
    f32x4 acc[2][2][4][2];
#pragma unroll
    for (int a = 0; a < 2; ++a)
#pragma unroll
        for (int b = 0; b < 2; ++b)
#pragma unroll
            for (int m = 0; m < 4; ++m)
#pragma unroll
                for (int n = 0; n < 2; ++n) acc[a][b][m][n] = (f32x4){0.f, 0.f, 0.f, 0.f};
    bf16x8 At[4][2], B0[2][2], B1[2][2];
    const char* cA = (const char*)g.A + (size_t)cur.pm * tstep; const char* cB = (const char*)g.Bt + (size_t)cur.pn * tstep;
    S.a_ready(cur);
    if constexpr (SP2) {
        PG8_STAGE(PG8_SB(0, 0), cB, voffB); PG8_STAGE(PG8_SB(0, 1), cB + hstep, voffB); PG8_STAGE(PG8_SA(0, 0), cA, voffA); PG8_STAGE(PG8_SA(0, 1), cA + hstep, voffA);
        if (wr == 1) PG8_BAR;
        PG8_WAIT_V(2); PG8_BAR;
        PG8_STAGE(PG8_SB(1, 0), cB + kstep, voffB); PG8_STAGE(PG8_SA(1, 0), cA + kstep, voffA); PG8_STAGE(PG8_SB(1, 1), cB + hstep + kstep, voffB);
        PG8_WAIT_V(6); PG8_BAR;
    } else {
        PG8_STAGE(PG8_SB(0, 0), cB, voffB); PG8_STAGE(PG8_SA(0, 0), cA, voffA); PG8_STAGE(PG8_SB(0, 1), cB + hstep, voffB); PG8_STAGE(PG8_SA(0, 1), cA + hstep, voffA);
        if (wr == 1) PG8_BAR;
        PG8_WAIT_V(4); PG8_BAR;
        PG8_STAGE(PG8_SB(1, 0), cB + kstep, voffB); PG8_STAGE(PG8_SA(1, 0), cA + kstep, voffA); PG8_STAGE(PG8_SB(1, 1), cB + hstep + kstep, voffB);
        PG8_WAIT_V(6); PG8_BAR;
    }
    for (;;) {
        const bool has_next = S.next(ui + 1, nxt);
        const char* nA = has_next ? (const char*)g.A + (size_t)nxt.pm * tstep : cA; const char* nB = has_next ? (const char*)g.Bt + (size_t)nxt.pn * tstep : cB;
        for (int t = 0; t < nt; t += 2) {
            const bool last = (t == nt - 2);
            const char* a1 = cA + (size_t)(t + 1) * kstep;
            const char* a2 = last ? nA : cA + (size_t)(t + 2) * kstep; const char* b2 = last ? nB : cB + (size_t)(t + 2) * kstep;
            const char* a3 = a2 + kstep; const char* b3 = b2 + kstep;
            if (last && has_next) S.a_ready(nxt);
            if constexpr (SP2) {
            PG8_LDB(B0, 0, 0); PG8_LDB(B1, 0, 1); PG8_SCHED; PG8_LDA(At, 0, 0); PG8_STAGE(PG8_SA(1, 1), a1 + hstep, voffA);
            PG8_WAIT_V(8); PG8_WAIT_L(0); PG8_BAR; PG8_MMA(0, 0, At, B0); PG8_MMA(0, 1, At, B1); PG8_BAR; PG8_SCHED;
            PG8_LDA(At, 0, 1); PG8_STAGE(PG8_SB(0, 0), b2, voffB); PG8_STAGE(PG8_SB(0, 1), b2 + hstep, voffB); PG8_STAGE(PG8_SA(0, 0), a2, voffA);
            PG8_WAIT_V(8); PG8_WAIT_L(0); PG8_BAR; PG8_MMA(1, 0, At, B0); PG8_MMA(1, 1, At, B1); PG8_BAR; PG8_SCHED;
            PG8_LDB(B0, 1, 0); PG8_LDB(B1, 1, 1); PG8_SCHED; PG8_LDA(At, 1, 0); PG8_STAGE(PG8_SA(0, 1), a2 + hstep, voffA);
            PG8_WAIT_V(8); PG8_WAIT_L(0); PG8_BAR; PG8_MMA(0, 0, At, B0); PG8_MMA(0, 1, At, B1); PG8_BAR; PG8_SCHED;
            PG8_LDA(At, 1, 1); PG8_STAGE(PG8_SB(1, 0), b3, voffB); PG8_STAGE(PG8_SB(1, 1), b3 + hstep, voffB); PG8_STAGE(PG8_SA(1, 0), a3, voffA);
            PG8_WAIT_V(8); PG8_WAIT_L(0); PG8_BAR; PG8_MMA(1, 0, At, B0); PG8_MMA(1, 1, At, B1); PG8_BAR; PG8_SCHED;
            } else {
            PG8_LDB(B0, 0, 0); PG8_SCHED; PG8_LDA(At, 0, 0); PG8_STAGE(PG8_SA(1, 1), a1 + hstep, voffA);
            PG8_WAIT_L(8); PG8_BAR; PG8_WAIT_L(0); PG8_MMA(0, 0, At, B0); PG8_BAR; PG8_SCHED;
            PG8_LDB(B1, 0, 1); PG8_STAGE(PG8_SB(0, 0), b2, voffB);
            PG8_BAR; PG8_WAIT_L(0); PG8_MMA(0, 1, At, B1); PG8_BAR;
            PG8_LDA(At, 0, 1); PG8_STAGE(PG8_SA(0, 0), a2, voffA);
            PG8_BAR; PG8_WAIT_L(0); PG8_MMA(1, 0, At, B0); PG8_BAR; PG8_SCHED;
            PG8_STAGE(PG8_SB(0, 1), b2 + hstep, voffB);
            PG8_WAIT_V(6); PG8_BAR; PG8_MMA(1, 1, At, B1); PG8_BAR;
            PG8_LDB(B0, 1, 0); PG8_SCHED; PG8_LDA(At, 1, 0); PG8_STAGE(PG8_SA(0, 1), a2 + hstep, voffA);
            PG8_WAIT_L(8); PG8_BAR; PG8_WAIT_L(0); PG8_MMA(0, 0, At, B0); PG8_BAR; PG8_SCHED;
            PG8_LDB(B1, 1, 1); PG8_STAGE(PG8_SB(1, 0), b3, voffB);
            PG8_BAR; PG8_WAIT_L(0); PG8_MMA(0, 1, At, B1); PG8_BAR;
            PG8_LDA(At, 1, 1); PG8_STAGE(PG8_SA(1, 0), a3, voffA);
            PG8_BAR; PG8_WAIT_L(0); PG8_MMA(1, 0, At, B0); PG8_BAR; PG8_SCHED;
            PG8_STAGE(PG8_SB(1, 1), b3 + hstep, voffB);
            PG8_WAIT_V(6); PG8_BAR; PG8_MMA(1, 1, At, B1); PG8_BAR;
            }
        }
        if constexpr (ALIGN_EPI) { if (wr == 0) PG8_BAR; }
        if constexpr (!Epi::AFTER_DRAIN) { E(acc, cur, wr, wc, fr, fq); S.done(cur); }
        if (!has_next) break;
#pragma unroll
        for (int a = 0; a < 2; ++a)
#pragma unroll
            for (int b = 0; b < 2; ++b)
#pragma unroll
                for (int m = 0; m < 4; ++m)
#pragma unroll
                    for (int n = 0; n < 2; ++n) acc[a][b][m][n] = (f32x4){0.f, 0.f, 0.f, 0.f};
        cur = nxt; cA = nA; cB = nB; ++ui;
        if constexpr (ALIGN_EPI) { if (wr == 1) PG8_BAR; }
    }
    PG8_WAIT_V(0);
    if constexpr (!ALIGN_EPI) { if (wr == 0) PG8_BAR; }
    PG8_BAR;
    if constexpr (Epi::AFTER_DRAIN) { E.fused(acc, cur, wr, wc, fr, fq, lds, wid, lane); S.done(cur); }
#undef PG8_SA
#undef PG8_SB
#undef PG8_STAGE
#undef PG8_LDA
#undef PG8_LDB
#undef PG8_MMA
#undef PG8_WAIT_V
#undef PG8_WAIT_L
#undef PG8_BAR
#undef PG8_SCHED
}
}
#define PG8_SP2 true
#define PG8_ALIGN true
namespace att {
typedef unsigned short bf16_t;
typedef __attribute__((address_space(3))) unsigned char* lptr;
typedef __attribute__((address_space(3))) const unsigned char* lcptr;
typedef short bf16x8 __attribute__((ext_vector_type(8)));
typedef short s16x4 __attribute__((ext_vector_type(4)));
typedef float f32x16 __attribute__((ext_vector_type(16)));
typedef float f32x4 __attribute__((ext_vector_type(4)));
typedef unsigned u32x4 __attribute__((ext_vector_type(4)));
typedef unsigned u32x2 __attribute__((ext_vector_type(2)));
typedef float f32x2_t __attribute__((ext_vector_type(2)));
typedef __bf16 bf16x2_t __attribute__((ext_vector_type(2)));
constexpr float LOG2E = 1.4426950408889634f;
constexpr int SLOT = 32768, LDS_CUM = 65536, LDS_TAB = 81920;
__device__ __forceinline__ unsigned cvtpk(float lo, float hi) { f32x2_t v = {lo, hi}; bf16x2_t b = __builtin_convertvector(v, bf16x2_t); return __builtin_bit_cast(unsigned, b); }
__device__ __forceinline__ float bf2f(unsigned short h) { return __uint_as_float(((unsigned)h) << 16); }
__device__ __forceinline__ void glds16(const void* gsrc, unsigned lds_dst) { unsigned keep;
    asm volatile("s_mov_b32 %0, m0\n\ts_mov_b32 m0, %2\n\ts_nop 0\n\tglobal_load_lds_dwordx4 %1, off\n\ts_mov_b32 m0, %0" : "=&s"(keep) : "v"(gsrc), "s"(lds_dst) : "memory"); }
__device__ __forceinline__ float fadd_s(float a, float b) { return a + b; }
__device__ __forceinline__ float fsub_s(float a, float b) { return a - b; }
__device__ __forceinline__ s16x4 vtr(lcptr p) { return __builtin_bit_cast(s16x4, __builtin_amdgcn_ds_read_tr16_b64_v4i16((__attribute__((address_space(3))) s16x4*)p)); }

template <int VD, int NK, int MODE>
__device__ __forceinline__ void attn_core(lptr lds, const bf16_t* Zb, int ldz, int qcol, int kcol0, int kcol1, int vcol, int q0w,
                                          int t_lo, int t_hi, int w_lo, int w_hi, int ksel, float nsl, int diag_t,
                                          f32x16 (&o)[2 * VD], float mref, float& l_run, int gcol, u32x4 (&gpre)[4]) {
    const int tid = threadIdx.x, lane = tid & 63, r32 = lane & 31, hi = lane >> 5;
    const int wv_ = __builtin_amdgcn_readfirstlane(tid >> 6);
    const int krow_ = 8 * wv_ + (lane >> 3), kchk_ = (lane & 7) ^ ((krow_ >> 1) & 7);
    const bf16_t* ksrc0 = Zb + (size_t)krow_ * ldz + kcol0 + kchk_ * 8;
    const bf16_t* ksrc1 = Zb + (size_t)krow_ * ldz + kcol1 + kchk_ * 8;
    const bf16_t* vsrc = Zb + (size_t)krow_ * ldz + vcol + ((lane & 7) ^ (4 * ((lane >> 4) & 1))) * 8;
    const unsigned lds0 = (unsigned)(uintptr_t)lds + (unsigned)wv_ * 1024u;
#define ATT_DMA(t, sl) do { const size_t go_ = (size_t)(t) * 64 * ldz; const unsigned d_ = (unsigned)__builtin_amdgcn_readfirstlane(lds0 + (unsigned)(sl) * SLOT); \
        glds16(ksrc0 + go_, d_); if (NK == 2) glds16(ksrc1 + go_, d_ + 8192u); glds16(vsrc + go_, d_ + 16384u); if (VD == 2) glds16(vsrc + go_ + 64, d_ + 24576u); } while (0)
#define ATT_DMA_WAIT() asm volatile("s_waitcnt vmcnt(0)" ::: "memory")
    bf16x8 qr[4];
    { const bf16_t* qp = Zb + (size_t)(q0w + r32) * ldz + qcol + hi * 8;
#pragma unroll
      for (int d0 = 0; d0 < 4; ++d0) qr[d0] = *(const bf16x8*)(qp + d0 * 16); }
#pragma unroll
    for (int i = 0; i < 2 * VD; ++i) o[i] = f32x16{};
    const float m = mref; float l = 0.f;
    const int qabs = q0w + r32;
    unsigned koff[4];
#pragma unroll
    for (int d0 = 0; d0 < 4; ++d0) koff[d0] = (unsigned)(ksel * 8192 + r32 * 128 + (((2 * d0 + hi) ^ ((r32 >> 1) & 7)) << 4));
    unsigned vfr[2];
#pragma unroll
    for (int dh = 0; dh < 2; ++dh) vfr[dh] = (unsigned)(16384 + (4 * hi + ((lane & 15) >> 2)) * 128 + ((dh ^ ((lane >> 3) & 1)) * 64) + ((lane >> 4) & 1) * 32 + (lane & 3) * 8);
    if (gcol >= 0) {
        const bf16_t* gp = Zb + (size_t)(q0w + r32) * ldz + gcol + 8 * hi;
#pragma unroll
        for (int i = 0; i < 4; ++i) gpre[i] = *(const u32x4*)(gp + 32 * (i >> 1) + 16 * (i & 1));
    }
    ATT_DMA(t_lo, 0); ATT_DMA_WAIT();
    if (gcol >= 0) asm volatile("" : "+v"(gpre[0]), "+v"(gpre[1]), "+v"(gpre[2]), "+v"(gpre[3]));
    __syncthreads();
    const float nnsl = -nsl;
    for (int t = t_lo; t <= t_hi; ++t) {
        const int cur = (t - t_lo) & 1;
        const bool act_ = (t >= w_lo && t <= w_hi);
        if (!act_) { if (t < t_hi) ATT_DMA(t + 1, cur ^ 1); }
        if (act_) {
            lcptr sb = (lcptr)(lds + cur * SLOT);
            bf16x8 kf[8];
#pragma unroll
            for (int d0 = 0; d0 < 4; ++d0) { kf[2 * d0] = *(const __attribute__((address_space(3))) bf16x8*)(sb + koff[d0]); kf[2 * d0 + 1] = *(const __attribute__((address_space(3))) bf16x8*)(sb + koff[d0] + 4096); }
            s16x4 vlo[8], vhh[8];
#pragma unroll
            for (int i = 0; i < 8; ++i) { vlo[i] = vtr(sb + vfr[i >> 2] + (i & 3) * 2048); vhh[i] = vtr(sb + vfr[i >> 2] + (i & 3) * 2048 + 1024); }
            __builtin_amdgcn_sched_barrier(0);
            f32x16 p0, p1;
            if (MODE == 0 || MODE == 2) {
                const float fq = (float)(qabs - 64 * t - 4 * hi);
                if (t == w_hi) {
#pragma unroll
                    for (int r = 0; r < 16; ++r) { const float c = (float)((r & 3) + 8 * (r >> 2));
                        p0[r] = __builtin_fmaf(nsl, __builtin_fabsf(fq - c), -m); p1[r] = __builtin_fmaf(nsl, __builtin_fabsf(fq - c - 32.0f), -m); }
                } else {
                    const float sh = __builtin_fmaf(nsl, fq, -m), n8 = 8.0f * nnsl, n32 = 32.0f * nnsl;
                    float bj_ = sh;
#pragma unroll
                    for (int j = 0; j < 4; ++j) { p0[4 * j] = bj_; p0[4 * j + 1] = fadd_s(p0[4 * j], nnsl); p0[4 * j + 2] = fadd_s(p0[4 * j + 1], nnsl); p0[4 * j + 3] = fadd_s(p0[4 * j + 2], nnsl);
                        if (j < 3) bj_ = fadd_s(bj_, n8); }
#pragma unroll
                    for (int r = 0; r < 16; ++r) p1[r] = fadd_s(p0[r], n32);
                }
            } else if (MODE == 1) {
                const __attribute__((address_space(3))) float* cl = (const __attribute__((address_space(3))) float*)(lds + LDS_CUM) + 64 * t + 4 * hi;
#pragma unroll
                for (int j = 0; j < 4; ++j) { const f32x4 c0 = *(const __attribute__((address_space(3))) f32x4*)(cl + 8 * j), c1 = *(const __attribute__((address_space(3))) f32x4*)(cl + 8 * j + 32);
#pragma unroll
                    for (int e = 0; e < 4; ++e) { p0[4 * j + e] = fsub_s(c0[e], m); p1[4 * j + e] = fsub_s(c1[e], m); } }
            } else {
                const __attribute__((address_space(3))) float* tb = (const __attribute__((address_space(3))) float*)(lds + LDS_TAB) + (575 - (qabs - 64 * t - 4 * hi));
#pragma unroll
                for (int r = 0; r < 16; ++r) { const int c = (r & 3) + 8 * (r >> 2); p0[r] = tb[c]; p1[r] = tb[c + 32]; }
            }
#pragma unroll
            for (int d0 = 0; d0 < 4; ++d0) {
                p0 = __builtin_amdgcn_mfma_f32_32x32x16_bf16(kf[2 * d0], qr[d0], p0, 0, 0, 0);
                p1 = __builtin_amdgcn_mfma_f32_32x32x16_bf16(kf[2 * d0 + 1], qr[d0], p1, 0, 0, 0);
            }
            if (t < t_hi) ATT_DMA(t + 1, cur ^ 1);

            if (MODE == 1) { if (t == diag_t) { const int qrel = (qabs & 63) - 4 * hi;
#pragma unroll
                    for (int r = 0; r < 16; ++r) { const int kv = (r & 3) + 8 * (r >> 2); if (kv > qrel) p0[r] = -INFINITY; if (kv + 32 > qrel) p1[r] = -INFINITY; } } }
            float sa = 0.f, sb_ = 0.f;
#pragma unroll
            for (int r = 0; r < 16; ++r) { p0[r] = __builtin_amdgcn_exp2f(p0[r]); p1[r] = __builtin_amdgcn_exp2f(p1[r]); sa = fadd_s(sa, p0[r]); sb_ = fadd_s(sb_, p1[r]); }
            l += sa + sb_;
            u32x4 pw[4];
            pw[0] = (u32x4){cvtpk(p0[0], p0[1]), cvtpk(p0[2], p0[3]), cvtpk(p0[4], p0[5]), cvtpk(p0[6], p0[7])};
            pw[1] = (u32x4){cvtpk(p0[8], p0[9]), cvtpk(p0[10], p0[11]), cvtpk(p0[12], p0[13]), cvtpk(p0[14], p0[15])};
            pw[2] = (u32x4){cvtpk(p1[0], p1[1]), cvtpk(p1[2], p1[3]), cvtpk(p1[4], p1[5]), cvtpk(p1[6], p1[7])};
            pw[3] = (u32x4){cvtpk(p1[8], p1[9]), cvtpk(p1[10], p1[11]), cvtpk(p1[12], p1[13]), cvtpk(p1[14], p1[15])};
#pragma unroll
            for (int i = 0; i < 8; ++i) { const bf16x8 vf = (bf16x8){vlo[i][0], vlo[i][1], vlo[i][2], vlo[i][3], vhh[i][0], vhh[i][1], vhh[i][2], vhh[i][3]};
                o[i >> 2] = __builtin_amdgcn_mfma_f32_32x32x16_bf16(vf, __builtin_bit_cast(bf16x8, pw[i & 3]), o[i >> 2], 0, 0, 0); }
            if (VD == 2) {
#pragma unroll
                for (int i = 0; i < 8; ++i) { const s16x4 lo = vtr(sb + vfr[i >> 2] + 8192 + (i & 3) * 2048), hh = vtr(sb + vfr[i >> 2] + 8192 + (i & 3) * 2048 + 1024);
                    const bf16x8 vf = (bf16x8){lo[0], lo[1], lo[2], lo[3], hh[0], hh[1], hh[2], hh[3]};
                    o[2 + (i >> 2)] = __builtin_amdgcn_mfma_f32_32x32x16_bf16(vf, __builtin_bit_cast(bf16x8, pw[i & 3]), o[2 + (i >> 2)], 0, 0, 0); }
            }
        }
        ATT_DMA_WAIT();
        __syncthreads();
    }
    { auto rr = __builtin_amdgcn_permlane32_swap(__float_as_uint(l), __float_as_uint(l), false, false); l = __uint_as_float(rr[0]) + __uint_as_float(rr[1]); }
    l_run = l;
#undef ATT_DMA
#undef ATT_DMA_WAIT
}
__device__ __forceinline__ void store_gated(const f32x16 (&o)[2], float inv, const u32x4 (&gpre)[4], bf16_t* orow, int hi) {
#pragma unroll
    for (int dh = 0; dh < 2; ++dh)
#pragma unroll
        for (int jp = 0; jp < 2; ++jp) {
            const int cb = 32 * dh + 16 * jp + 8 * hi;
            const u32x4 L = gpre[dh * 2 + jp];
            const auto g0 = __builtin_amdgcn_permlane32_swap(L.x, L.z, false, false), g1 = __builtin_amdgcn_permlane32_swap(L.y, L.w, false, false);
            u32x2 w[2];
#pragma unroll
            for (int q = 0; q < 2; ++q) { const int j = 2 * jp + q; const unsigned gx = q ? g0[1] : g0[0], gy = q ? g1[1] : g1[0];
                const float a0 = __uint_as_float(gx << 16), a1 = __uint_as_float(gx & 0xffff0000u), a2 = __uint_as_float(gy << 16), a3 = __uint_as_float(gy & 0xffff0000u);
                w[q].x = cvtpk(o[dh][4 * j] * inv * a0, o[dh][4 * j + 1] * inv * a1); w[q].y = cvtpk(o[dh][4 * j + 2] * inv * a2, o[dh][4 * j + 3] * inv * a3); }
            const auto s0 = __builtin_amdgcn_permlane32_swap(w[0].x, w[1].x, false, false), s1 = __builtin_amdgcn_permlane32_swap(w[0].y, w[1].y, false, false);
            *(u32x4*)(orow + cb) = (u32x4){s0[0], s1[0], s0[1], s1[1]};
        }
}
}
typedef unsigned short bf16;
typedef float f32x4 __attribute__((ext_vector_type(4)));
typedef float f32x16 __attribute__((ext_vector_type(16)));
typedef unsigned v4u __attribute__((ext_vector_type(4)));
typedef unsigned v2u __attribute__((ext_vector_type(2)));
#define LAS __attribute__((address_space(3)))
constexpr int NWAVES = 8, NTHR = 512;
constexpr int M = 16384, DM = 1024, SEQ = 4096;
constexpr int N0 = 4096, LDW0 = 4104, N1 = 3328;
constexpr size_t MiB = 1u << 20;
constexpr size_t WS_CTL = 0, WS_BT0 = 2 * MiB, WS_BTO0 = 10 * MiB, WS_BT1 = 12 * MiB, WS_BTO1 = 19 * MiB, WS_RS0 = 21 * MiB, WS_LF = 22 * MiB, WS_SSQ = 24 * MiB,
                 WS_XB = 32 * MiB, WS_Z = 64 * MiB, WS_MIX = 192 * MiB, WS_END = 224 * MiB;
constexpr int RING_BYTES = 131072, MISC_OFF = RING_BYTES, LDS_BYTES = RING_BYTES + 4096;
constexpr float LOG2E = 1.4426950408889634f;
constexpr int CW_BAR = 4096;

__device__ __forceinline__ unsigned f2bf(float f) { unsigned u = __builtin_bit_cast(unsigned, f); return (u + 0x7fffu + ((u >> 16) & 1u)) >> 16; }
__device__ __forceinline__ unsigned pk2(float lo, float hi) { return f2bf(lo) | (f2bf(hi) << 16); }
__device__ __forceinline__ float wave_sum(float v) {
#pragma unroll
    for (int o = 1; o < 64; o <<= 1) v += __shfl_xor(v, o);
    return v;
}
__device__ __forceinline__ void p0_transpose_item(const float* W, int ldw, int N, const float* gain, bool permute, int swa, int swb, bf16* WT, LAS float* scr, int item, int lane, bool nts = false) {
    const int nblk = N / 32, kb = item / nblk, nb = item % nblk, k0 = 64 * kb, n0 = 32 * nb;
    float wv[32];
#pragma unroll
    for (int i = 0; i < 32; ++i) { const int kk = 2 * i + (lane >> 5); wv[i] = __builtin_nontemporal_load(W + (size_t)(k0 + kk) * ldw + n0 + (lane & 31)); }
    const float gl = gain ? gain[k0 + lane] : 1.0f;
#pragma unroll
    for (int i = 0; i < 32; ++i) { const int kk = 2 * i + (lane >> 5); scr[kk * 33 + (lane & 31)] = wv[i] * __shfl(gl, kk); }
    asm volatile("s_waitcnt lgkmcnt(0)" ::: "memory");
    const int c = lane & 7;
#pragma unroll
    for (int j = 0; j < 4; ++j) { const int n = (lane >> 3) + 8 * j; const LAS float* s = scr + (8 * c) * 33 + n;
        v4u o; o.x = pk2(s[0 * 33], s[1 * 33]); o.y = pk2(s[2 * 33], s[3 * 33]); o.z = pk2(s[4 * 33], s[5 * 33]); o.w = pk2(s[6 * 33], s[7 * 33]);
        int nl = n0 + n;
        if (permute) { int tile = nl >> 8; tile = (tile == swa) ? swb : (tile == swb ? swa : tile);
            const int t = nl & 255; nl = (tile << 8) | (((t >> 5) & 1) << 7) | (((t >> 6) & 3) << 5) | (t & 31); }
        if (nts) __builtin_nontemporal_store(o, (v4u*)(WT + (size_t)nl * 1024 + k0 + 8 * c)); else *(v4u*)(WT + (size_t)nl * 1024 + k0 + 8 * c) = o; }
    asm volatile("s_waitcnt lgkmcnt(0)" ::: "memory");
}

struct Params { const float* in[23]; float* out; unsigned char* ws; int ph_lo, ph_hi; };

__device__ __forceinline__ void p0_prologue(const Params& P, LAS unsigned char* lds, int tid, int lane, int wave) {
    const int G = gridDim.x, gw = blockIdx.x * NWAVES + wave, NGW = G * NWAVES;
    unsigned char* ws = P.ws;
    LAS float* wf = (LAS float*)(lds + 98304);
    { float t0[16], t1[16];
#pragma unroll
      for (int u = 0; u < 16; ++u) { const int i = tid + NTHR * u, k = i >> 3, j = i & 7; t0[u] = P.in[1][k]; t1[u] = P.in[2][(size_t)k * LDW0 + N0 + j]; }
#pragma unroll
      for (int u = 0; u < 16; ++u) { const int i = tid + NTHR * u, k = i >> 3, j = i & 7; wf[j * 1024 + k] = t0[u] * t1[u]; } }
    LAS float* scr = (LAS float*)(lds + wave * 8704);
    constexpr int I0 = 16 * (N0 / 32);
    for (int it = gw; it < I0; it += NGW) p0_transpose_item(P.in[2], LDW0, N0, P.in[1], true, -1, -1, (bf16*)(ws + WS_BT0), scr, it, lane);
    __syncthreads();
    const float* x = P.in[0]; bf16* xb = (bf16*)(ws + WS_XB); float* rs0 = (float*)(ws + WS_RS0); float* lf = (float*)(ws + WS_LF);
    f32x4 vn[4];
    if (gw < M) { const f32x4* xr = (const f32x4*)(x + (size_t)gw * DM) + lane;
#pragma unroll
        for (int j = 0; j < 4; ++j) vn[j] = __builtin_nontemporal_load(xr + 64 * j); }
    for (int mrow = gw; mrow < M; mrow += NGW) {
        f32x4 v[4];
#pragma unroll
        for (int j = 0; j < 4; ++j) v[j] = vn[j];
        if (mrow + NGW < M) { const f32x4* xr = (const f32x4*)(x + (size_t)(mrow + NGW) * DM) + lane;
#pragma unroll
            for (int j = 0; j < 4; ++j) vn[j] = __builtin_nontemporal_load(xr + 64 * j); }
        float s = 0.f; float dj[8];
#pragma unroll
        for (int j = 0; j < 8; ++j) dj[j] = 0.f;
#pragma unroll
        for (int j = 0; j < 4; ++j) { s += (v[j][0] * v[j][0] + v[j][1] * v[j][1]) + (v[j][2] * v[j][2] + v[j][3] * v[j][3]);
#pragma unroll
            for (int jj = 0; jj < 8; ++jj) { const f32x4 w = *(const LAS f32x4*)(wf + jj * 1024 + 4 * (lane + 64 * j));
                dj[jj] += (v[j][0] * w[0] + v[j][1] * w[1]) + (v[j][2] * w[2] + v[j][3] * w[3]); } }
        const float rstd = __builtin_amdgcn_rsqf(wave_sum(s) * (1.0f / DM) + 1e-6f);
        float r4[4], r2[2], r1;
#pragma unroll
        for (int i = 0; i < 4; ++i) { const float keep = (lane & 1) ? dj[4 + i] : dj[i], send = (lane & 1) ? dj[i] : dj[4 + i]; r4[i] = keep + __shfl_xor(send, 1); }
#pragma unroll
        for (int i = 0; i < 2; ++i) { const float keep = (lane & 2) ? r4[2 + i] : r4[i], send = (lane & 2) ? r4[i] : r4[2 + i]; r2[i] = keep + __shfl_xor(send, 2); }
        { const float keep = (lane & 4) ? r2[1] : r2[0], send = (lane & 4) ? r2[0] : r2[1]; r1 = keep + __shfl_xor(send, 4); }
        r1 += __shfl_xor(r1, 8); r1 += __shfl_xor(r1, 16); r1 += __shfl_xor(r1, 32);
        const int jo = 4 * (lane & 1) + 2 * ((lane >> 1) & 1) + ((lane >> 2) & 1);
        v2u* o8 = (v2u*)(xb + (size_t)mrow * DM) + lane;
#pragma unroll
        for (int j = 0; j < 4; ++j) { v2u w; w.x = pk2(v[j][0], v[j][1]); w.y = pk2(v[j][2], v[j][3]); o8[64 * j] = w; }
        if (lane == 0) rs0[mrow] = rstd;
        if (lane < 8) { const float z = r1 * rstd + P.in[13][jo]; const float ls = fminf(z, 0.f) - log1pf(expf(-fabsf(z)));
            const int b = mrow >> 12, sidx = mrow & 4095; lf[(size_t)(b * 8 + jo) * SEQ + sidx] = ls; }
    }
    if (wave == 0 && blockIdx.x == 8 % gridDim.x) {
        const float a = wave_sum(P.in[6][lane] * P.in[7][lane]), b = wave_sum(P.in[8][lane] * P.in[9][lane]);
        float ga = fabsf(P.in[4][lane] * P.in[5][lane]), gb = fabsf(P.in[11][lane] * P.in[12][lane]), gc = fabsf(P.in[17][lane] * P.in[18][lane]);
#pragma unroll
        for (int o = 1; o < 64; o <<= 1) { ga = fmaxf(ga, __shfl_xor(ga, o)); gb = fmaxf(gb, __shfl_xor(gb, o)); gc = fmaxf(gc, __shfl_xor(gc, o)); }
        if (lane == 0) { float* ctl = (float*)(ws + WS_CTL); ctl[0] = expf(a) - expf(b) + 0.2f;
            ctl[1] = 8.0f * ga * LOG2E * 1.02f + 0.25f; ctl[2] = 8.0f * gb * LOG2E * 1.02f + 0.25f; ctl[3] = 8.0f * gc * LOG2E * 1.02f + 0.25f; }
    }
    if (wave == 0) {
        for (int hh = blockIdx.x; hh < 8; hh += gridDim.x) {
            float gd = fabsf(P.in[20][lane] * P.in[21][lane]), t = -INFINITY;
            for (int i = lane; i < 320; i += 64) t = fmaxf(t, P.in[22][hh * 320 + i]);
#pragma unroll
            for (int o = 1; o < 64; o <<= 1) { gd = fmaxf(gd, __shfl_xor(gd, o)); t = fmaxf(t, __shfl_xor(t, o)); }
            if (lane == 0) ((float*)(ws + WS_CTL))[8 + hh] = 8.0f * gd * LOG2E * 1.02f + 0.25f + t * LOG2E;
        }
    }
}
constexpr int LATE_W_ITEMS = (16 * (DM / 32) + 16 * (N1 / 32) + 16 * (DM / 32)) / 8;
__device__ __forceinline__ void late_weight_item(const Params& P, LAS unsigned char* lds, int bitem, int lane, int wave) {
    constexpr int IO = 16 * (DM / 32), I1 = 16 * (N1 / 32);
    LAS float* scr = (LAS float*)(lds + wave * 8704);
    int r = bitem * 8 + wave;
    if (r < IO) p0_transpose_item(P.in[3], DM, DM, nullptr, false, -1, -1, (bf16*)(P.ws + WS_BTO0), scr, r, lane, true);
    else if (r < IO + I1) p0_transpose_item(P.in[15], N1, N1, P.in[14], true, 4, 12, (bf16*)(P.ws + WS_BT1), scr, r - IO, lane, true);
    else p0_transpose_item(P.in[16], DM, DM, nullptr, false, -1, -1, (bf16*)(P.ws + WS_BTO1), scr, r - IO - I1, lane, true);
    __syncthreads();
}
#define XB_TMO      128
#define XB_XCNT(j)  (256  + 64 * (j))
#define XB_XSUB(j)  (1280 + 64 * (j))
#define XB_XGEN(j)  (2304 + 64 * (j))
#define XB_TOP      3328
#define XB_TOPGEN   3392
#define XCD_BAR_WORDS 3456
#define XB_SPIN_CAP (1u << 18)

__device__ __forceinline__ unsigned xb_ld(unsigned* p)              { return __hip_atomic_load(p, __ATOMIC_RELAXED, __HIP_MEMORY_SCOPE_AGENT); }
__device__ __forceinline__ unsigned xb_add(unsigned* p, unsigned v) { return __hip_atomic_fetch_add(p, v, __ATOMIC_RELAXED, __HIP_MEMORY_SCOPE_AGENT); }
__device__ __forceinline__ unsigned xb_xcc_id() { return (unsigned)__builtin_amdgcn_s_getreg((3 << 11) | 20) & 0xFu; }
#define XB_SPIN(cond, bar) do { unsigned _sp = 0; while (cond) { __builtin_amdgcn_s_sleep(1); \
    if ((++_sp & 255u) == 0u) { if (xb_ld(&(bar)[XB_TMO])) break; if (_sp > XB_SPIN_CAP) { atomicAdd(&(bar)[XB_TMO], 1u); break; } } } } while (0)

struct XcdBarrier {
    unsigned* bar; unsigned x;
    volatile LAS unsigned* st;
};

__device__ __forceinline__ XcdBarrier xcd_barrier_post(unsigned* bar, volatile LAS unsigned* st) {
    XcdBarrier b; b.bar = bar; b.x = xb_xcc_id(); b.st = st;
    if (threadIdx.x == 0) (void)xb_add(&bar[XB_XCNT(b.x)], 1u);
    return b;
}
__device__ __forceinline__ void xcd_barrier_complete(unsigned* bar, unsigned x, unsigned& nloc, unsigned& nx) {
    const unsigned G = gridDim.x * gridDim.y * gridDim.z;
    unsigned sum, cnt, mine, sp = 0u;
    for (;;) {
        sum = 0u; cnt = 0u; mine = 0u;
#pragma unroll
        for (unsigned j = 0; j < 16; ++j) { const unsigned c = xb_ld(&bar[XB_XCNT(j)]); sum += c; cnt += (c > 0u) ? 1u : 0u; mine = (j == x) ? c : mine; }
        if (sum == G) break;
        __builtin_amdgcn_s_sleep(1);
        if ((++sp & 255u) == 0u) { if (xb_ld(&bar[XB_TMO])) break; if (sp > XB_SPIN_CAP) { atomicAdd(&bar[XB_TMO], 1u); break; } }
    }
    nloc = mine > 0u ? mine : 1u; nx = cnt > 0u ? cnt : 1u;
}

__device__ __forceinline__ void xcd_barrier(const XcdBarrier& b) {
    asm volatile("s_waitcnt vmcnt(0)" ::: "memory");
    __syncthreads();
    if (threadIdx.x == 0) {
        unsigned* bar = b.bar;
        __builtin_amdgcn_s_waitcnt(0);
        unsigned nloc = b.st[0], nx = b.st[1];
        if (nloc == 0u) { xcd_barrier_complete(bar, b.x, nloc, nx); b.st[0] = nloc; b.st[1] = nx; }
        const unsigned old = xb_add(&bar[XB_XSUB(b.x)], 1u);
        const unsigned gen = old / nloc;
        if (old + 1u == (gen + 1u) * nloc) {
            __builtin_amdgcn_fence(__ATOMIC_RELEASE, "agent");
            asm volatile("s_waitcnt vmcnt(0)" ::: "memory");
            const unsigned og = xb_add(&bar[XB_TOP], 1u);
            const unsigned tg = og / nx;
            if (og + 1u == (tg + 1u) * nx) xb_add(&bar[XB_TOPGEN], 1u);
            else XB_SPIN(xb_ld(&bar[XB_TOPGEN]) == tg, bar);
            __builtin_amdgcn_fence(__ATOMIC_ACQUIRE, "agent");
            xb_add(&bar[XB_XGEN(b.x)], 1u);
            asm volatile("s_waitcnt vmcnt(0)" ::: "memory");
        } else {
            XB_SPIN(xb_ld(&bar[XB_XGEN(b.x)]) == gen, bar);
            __builtin_amdgcn_fence(__ATOMIC_ACQUIRE, "agent");
            asm volatile("s_waitcnt vmcnt(0)" ::: "memory");
        }
    }
    __syncthreads();
}

__device__ __forceinline__ void unit_A(const Params& P, LAS unsigned char* lds, int bh, int qa, int tid, int lane, int wave) {
    const int b = bh >> 2, h = bh & 3, r32 = lane & 31, hi = lane >> 5;
    const bf16* Zb = (const bf16*)(P.ws + WS_Z) + (size_t)b * SEQ * N0;
    const int c = wave >> 2, j = wave & 3, q0w = 128 * qa + 32 * j, chunk = 2 * qa + (j >> 1);
    const float slope = exp2f(-2.0f * (float)(h + 1));
    const float thr = 150.0f / (slope * LOG2E);
    const int t_lo = max(0, (int)ceilf(((float)(128 * qa) - thr - 63.0f) * (1.0f / 64.0f))), w_lo = max(0, (int)ceilf(((float)q0w - thr - 63.0f) * (1.0f / 64.0f)));
    f32x16 o[4]; float l; att::u32x4 gdum[4];
    att::attn_core<2, 2, 0>(lds, Zb, N0, h * 128 + c * 64, 512 + h * 128, 512 + h * 128 + 64, 1024 + h * 128, q0w, t_lo, 2 * qa + 1, w_lo, chunk, c, -slope * LOG2E, -1, o, ((const float*)(P.ws + WS_CTL))[1], l, -1, gdum);
    const float inv = __builtin_amdgcn_rcpf(l);
    LAS f32x4* xs = (LAS f32x4*)lds + j * 1024 + lane;
    if (c == 1) {
#pragma unroll
        for (int i = 0; i < 4; ++i)
#pragma unroll
            for (int r4 = 0; r4 < 4; ++r4) xs[(i * 4 + r4) * 64] = (f32x4){o[i][4 * r4] * inv, o[i][4 * r4 + 1] * inv, o[i][4 * r4 + 2] * inv, o[i][4 * r4 + 3] * inv};
    }
    __syncthreads();
    if (c == 0) {
        const float lam = ((const float*)(P.ws + WS_CTL))[0];
        float ss = 0.f;
#pragma unroll
        for (int i = 0; i < 4; ++i)
#pragma unroll
            for (int r4 = 0; r4 < 4; ++r4) { const f32x4 x1 = xs[(i * 4 + r4) * 64];
#pragma unroll
                for (int e = 0; e < 4; ++e) { const float v = o[i][4 * r4 + e] * inv - lam * x1[e]; o[i][4 * r4 + e] = v; ss += v * v; } }
        ss += __shfl_xor(ss, 32);
        const float rn = 0.8f * __builtin_amdgcn_rsqf(ss * (1.0f / 128.0f) + 1e-6f);
        const size_t row = (size_t)b * SEQ + q0w + r32;
        const bf16* grow = (const bf16*)(P.ws + WS_Z) + row * N0 + 1536 + h * 128;
        bf16* orow = (bf16*)(P.ws + WS_MIX) + row * DM + h * 128;
        const float* sg = P.in[10];
#pragma unroll
        for (int i = 0; i < 4; ++i)
#pragma unroll
            for (int jp = 0; jp < 2; ++jp) {
                const int cb = 32 * i + 16 * jp + 8 * hi;
                const v4u L = *(const v4u*)(grow + cb);
                const auto g0 = __builtin_amdgcn_permlane32_swap(L.x, L.z, false, false), g1 = __builtin_amdgcn_permlane32_swap(L.y, L.w, false, false);
                v2u w[2];
#pragma unroll
                for (int q = 0; q < 2; ++q) { const int jj = 2 * jp + q, d = 32 * i + 8 * jj + 4 * hi; const unsigned gx = q ? g0[1] : g0[0], gy = q ? g1[1] : g1[0];
                    const f32x4 s4 = *(const f32x4*)(sg + d);
                    const float a0 = __uint_as_float(gx << 16), a1 = __uint_as_float(gx & 0xffff0000u), a2 = __uint_as_float(gy << 16), a3 = __uint_as_float(gy & 0xffff0000u);
                    w[q].x = att::cvtpk(o[i][4 * jj] * rn * s4[0] * a0, o[i][4 * jj + 1] * rn * s4[1] * a1); w[q].y = att::cvtpk(o[i][4 * jj + 2] * rn * s4[2] * a2, o[i][4 * jj + 3] * rn * s4[3] * a3); }
                const auto s0 = __builtin_amdgcn_permlane32_swap(w[0].x, w[1].x, false, false), s1 = __builtin_amdgcn_permlane32_swap(w[0].y, w[1].y, false, false);
                *(v4u*)(orow + cb) = (v4u){s0[0], s1[0], s0[1], s1[1]};
            }
    }
    __syncthreads();
}
__device__ __forceinline__ void unit_B(const Params& P, LAS unsigned char* lds, int bh, int qb, int tid, int lane, int wave) {
    const int b = bh >> 3, h = bh & 7, r32 = lane & 31, hi = lane >> 5;
    const bf16* Zb = (const bf16*)(P.ws + WS_Z) + (size_t)b * SEQ * N0;
    const int q0w = 256 * qb + 32 * wave, chunk = 4 * qb + (wave >> 1);
    {
        const float* lfs = (const float*)(P.ws + WS_LF) + (size_t)bh * SEQ;
        LAS float* cl = (LAS float*)(lds + att::LDS_CUM);
        LAS float* part = (LAS float*)(lds + MISC_OFF + 256);
        const int n = 256 * (qb + 1); const bool mine = tid * 8 < n;
        f32x4 a4 = (f32x4){0.f, 0.f, 0.f, 0.f}, b4 = a4;
        if (mine) { const f32x4* src = (const f32x4*)(lfs + tid * 8); a4 = src[0]; b4 = src[1]; }
        float v0 = a4[0], v1 = v0 + a4[1], v2 = v1 + a4[2], v3 = v2 + a4[3], v4 = v3 + b4[0], v5 = v4 + b4[1], v6 = v5 + b4[2], v7 = v6 + b4[3];
        float inc = v7;
#pragma unroll
        for (int o_ = 1; o_ < 64; o_ <<= 1) { const float t_ = __shfl_up(inc, o_); if (lane >= o_) inc += t_; }
        if (lane == 63) part[wave] = inc;
        __syncthreads();
        float base = inc - v7;
#pragma unroll
        for (int w_ = 0; w_ < 8; ++w_) if (w_ < wave) base += part[w_];
        if (tid == 32 * qb) part[8] = v0 + base;
        __syncthreads();
        const float cref = part[8];
        if (mine) { LAS f32x4* dst = (LAS f32x4*)(cl + tid * 8);
            dst[0] = (f32x4){(cref - (v0 + base)) * LOG2E, (cref - (v1 + base)) * LOG2E, (cref - (v2 + base)) * LOG2E, (cref - (v3 + base)) * LOG2E};
            dst[1] = (f32x4){(cref - (v4 + base)) * LOG2E, (cref - (v5 + base)) * LOG2E, (cref - (v6 + base)) * LOG2E, (cref - (v7 + base)) * LOG2E}; }
    }
    __syncthreads();
    const float mrow = ((const float*)(P.ws + WS_CTL))[2] + ((const LAS float*)(lds + att::LDS_CUM))[q0w + r32];
    int t_lo, w_lo;
    { const LAS float* cl = (const LAS float*)(lds + att::LDS_CUM); const int ti = lane <= 4 * qb + 3 ? lane : 4 * qb + 3; const float ce = cl[64 * ti + 63];
      const unsigned long long kw = __ballot(ce - cl[q0w] >= -150.0f), kb = __ballot(ce - cl[256 * qb] >= -150.0f);
      w_lo = kw ? (int)__builtin_ctzll(kw) : chunk; t_lo = kb ? (int)__builtin_ctzll(kb) : 4 * qb; if (w_lo > chunk) w_lo = chunk; }
    t_lo = __builtin_amdgcn_readfirstlane(t_lo); w_lo = __builtin_amdgcn_readfirstlane(w_lo);
    f32x16 o[2]; float l; att::u32x4 gpre[4];
    att::attn_core<1, 1, 1>(lds, Zb, N0, 2048 + h * 64, 2560 + h * 64, 0, 3072 + h * 64, q0w, t_lo, 4 * qb + 3, w_lo, chunk, 0, 0.f, chunk, o, mrow, l, 3584 + h * 64, gpre);
    const size_t row = (size_t)b * SEQ + q0w + r32;
    att::store_gated(o, __builtin_amdgcn_rcpf(l), gpre, (bf16*)(P.ws + WS_MIX) + row * DM + 512 + h * 64, hi);
}
__device__ __forceinline__ void unit_C(const Params& P, LAS unsigned char* lds, int b, int kvh, int c, int tid, int lane, int wave) {
    const int r32 = lane & 31, hi = lane >> 5, h = kvh * 4 + (wave >> 1);
    const bf16* Zb = (const bf16*)(P.ws + WS_Z) + (size_t)b * SEQ * N1;
    const int q0w = 64 * c + 32 * (wave & 1);
    const int t_lo = (c - 2) > 0 ? c - 2 : 0;
    const float slope = exp2f(-(float)(h + 1));
    const float m = ((const float*)(P.ws + WS_CTL))[3];
    f32x16 o[2]; float l; att::u32x4 gpre[4];
    att::attn_core<1, 1, 2>(lds, Zb, N1, h * 64, 512 + kvh * 64, 0, 640 + kvh * 64, q0w, t_lo, c, t_lo, c, 0, -slope * LOG2E, -1, o, m, l, 768 + h * 64, gpre);
    l += exp2f(P.in[19][h] * LOG2E - m);
    const size_t row = (size_t)b * SEQ + q0w + r32;
    att::store_gated(o, __builtin_amdgcn_rcpf(l), gpre, (bf16*)(P.ws + WS_MIX) + row * DM + h * 64, hi);
}
__device__ __forceinline__ void unit_D(const Params& P, LAS unsigned char* lds, int bh, int qb, int tid, int lane, int wave) {
    const int b = bh >> 3, h = bh & 7, r32 = lane & 31, hi = lane >> 5;
    const bf16* Zb = (const bf16*)(P.ws + WS_Z) + (size_t)b * SEQ * N1;
    const int q0w = 256 * qb + 32 * wave, chunk = 4 * qb + (wave >> 1);
    const int t_lo = (4 * qb - 8) > 0 ? 4 * qb - 8 : 0, w_lo = (chunk - 8) > 0 ? chunk - 8 : 0;
    { LAS float* tb = (LAS float*)(lds + att::LDS_TAB); const float* rt = P.in[22] + h * 320;
      const float mh = ((const float*)(P.ws + WS_CTL))[8 + h];
      for (int i = tid; i < 640; i += NTHR) { const int e = 638 - i; tb[i] = rt[e < 319 ? (e < 0 ? 0 : e) : 319] * LOG2E - mh; } }
    const float m = ((const float*)(P.ws + WS_CTL))[8 + h];
    f32x16 o[2]; float l; att::u32x4 gpre[4];
    att::attn_core<1, 1, 3>(lds, Zb, N1, 1280 + h * 64, 1792 + h * 64, 0, 2304 + h * 64, q0w, t_lo, 4 * qb + 3, w_lo, chunk, 0, 0.f, -1, o, m, l, 2816 + h * 64, gpre);
    const size_t row = (size_t)b * SEQ + q0w + r32;
    att::store_gated(o, __builtin_amdgcn_rcpf(l), gpre, (bf16*)(P.ws + WS_MIX) + row * DM + 512 + h * 64, hi);
}
__device__ __forceinline__ int queue_next(unsigned* ctr, LAS unsigned char* lds, int tid) {
    volatile LAS int* w = (volatile LAS int*)(lds + MISC_OFF);
    if (tid == 0) w[0] = (int)atomicAdd(ctr, 1u);
    __syncthreads();
    const int it = w[0];
    __syncthreads();
    return it;
}

__global__ void __launch_bounds__(NTHR, 2) trunk_fwd(Params P) {
    extern __shared__ __attribute__((aligned(16))) unsigned char lds_raw[];
    LAS unsigned char* lds = (LAS unsigned char*)lds_raw;
    const int tid = threadIdx.x, lane = tid & 63, wave = __builtin_amdgcn_readfirstlane(tid >> 6);
    const int lo = P.ph_lo, hi_ = P.ph_hi, G = gridDim.x;
    unsigned char* ws = P.ws;
#define IN(k) (lo <= (k) && (k) < hi_)
    { volatile LAS unsigned* mz = (volatile LAS unsigned*)(lds + MISC_OFF); if (tid < 64) mz[tid] = 0u; }
    __syncthreads();
    XcdBarrier bar = xcd_barrier_post((unsigned*)(ws + WS_CTL) + CW_BAR, (volatile LAS unsigned*)(lds + MISC_OFF + 64));
    if (P.ph_hi > 1000) cg::this_grid().sync();
#define SEAM(k) do { if (IN(k) && IN((k) + 1)) { xcd_barrier(bar); } } while (0)
    if (IN(0)) { p0_prologue(P, lds, tid, lane, wave); __syncthreads();
#if PROBE_REP0
        p0_prologue(P, lds, tid, lane, wave); __syncthreads();
#endif
    }
    SEAM(0);
    if (IN(1)) {
        pg8::Gemm g{(const bf16*)(ws + WS_XB), (const bf16*)(ws + WS_BT0), M, N0, DM}; pg8::StaticOrder S; S.init(M, N0, G, (int)blockIdx.x);
        pg8::EpiIn E{(bf16*)(ws + WS_Z), N0, (const float*)(ws + WS_RS0), nullptr,
                     {8, 16, 24, 32, 40, 48, 56, 64}, {1, 2, 0, 3, 1, 2, 0, 3}, {P.in[4], P.in[5], nullptr, nullptr, P.in[11], P.in[12], nullptr, nullptr}, 0, -1, -1};
        pg8::gemm_phase<pg8::EpiIn, pg8::StaticOrder, PG8_ALIGN, PG8_SP2>(lds, g, S, E);
        __syncthreads();
#if PROBE_REP1
        pg8::gemm_phase<pg8::EpiIn, pg8::StaticOrder, PG8_ALIGN, PG8_SP2>(lds, g, S, E);
        __syncthreads();
#endif
    }
    SEAM(1);
    if (IN(2)) {
        unsigned* ctr = (unsigned*)(ws + WS_CTL) + 64;
        int it = (int)blockIdx.x;
        for (;;) {
            if (it >= 1024) break;
            const int pp = it >> 6, r = it & 63;
            if (r < 16) unit_A(P, lds, r, 31 - 2 * pp, tid, lane, wave);
            else if (r < 48) unit_B(P, lds, r - 16, 15 - pp, tid, lane, wave);
            else unit_A(P, lds, r - 48, 30 - 2 * pp, tid, lane, wave);
            it = G + queue_next(ctr, lds, tid);
        }
        while (it < 1024 + LATE_W_ITEMS) { late_weight_item(P, lds, it - 1024, lane, wave); it = G + queue_next(ctr, lds, tid); }
    }
    SEAM(2);
    if (IN(3)) {
        pg8::Gemm g{(const bf16*)(ws + WS_MIX), (const bf16*)(ws + WS_BTO0), M, DM, DM}; pg8::StaticOrder S; S.init(M, DM, G, (int)blockIdx.x);
        pg8::EpiOut E{P.in[0], nullptr, nullptr, (bf16*)(ws + WS_XB), (float*)(ws + WS_SSQ)};
        pg8::gemm_phase<pg8::EpiOut, pg8::StaticOrder, false, PG8_SP2>(lds, g, S, E);
        __syncthreads();
#if PROBE_REP3
        pg8::gemm_phase<pg8::EpiOut, pg8::StaticOrder, false, PG8_SP2>(lds, g, S, E);
        __syncthreads();
#endif
    }
    SEAM(3);
    if (IN(4)) {
        pg8::Gemm g{(const bf16*)(ws + WS_XB), (const bf16*)(ws + WS_BT1), M, 3072, DM}; pg8::StaticOrder S; S.init(M, 3072, G, (int)blockIdx.x);
        pg8::EpiIn E{(bf16*)(ws + WS_Z), N1, nullptr, (const float*)(ws + WS_SSQ),
                     {8, 10, 12, 20, 28, 36, 44, 52}, {1, 2, 0, 3, 1, 2, 0, 3}, {P.in[17], P.in[18], nullptr, nullptr, P.in[20], P.in[21], nullptr, nullptr}, 0, 4, 12};
        pg8::gemm_phase<pg8::EpiIn, pg8::StaticOrder, PG8_ALIGN, PG8_SP2>(lds, g, S, E);
        __syncthreads();
    }
    SEAM(4);
    if (IN(5)) {
        unsigned* late = (unsigned*)(ws + WS_CTL) + 320;
        {
            pg8::Gemm g2{(const bf16*)(ws + WS_XB), (const bf16*)(ws + WS_BT1) + (size_t)3072 * 1024, M, 256, DM}; pg8::StaticOrder S2; S2.init(M, 256, G, (int)blockIdx.x);
            pg8::Unit u0; int n_mine = 0; while (S2.next(n_mine, u0)) ++n_mine;
            const bool mine = n_mine > 0;
            pg8::EpiIn E2{(bf16*)(ws + WS_Z), N1, nullptr, (const float*)(ws + WS_SSQ),
                          {8, 10, 12, 20, 28, 36, 44, 52}, {1, 2, 0, 3, 1, 2, 0, 3}, {P.in[17], P.in[18], nullptr, nullptr, P.in[20], P.in[21], nullptr, nullptr}, 12, 4, 12};
            pg8::gemm_phase<pg8::EpiIn, pg8::StaticOrder, PG8_ALIGN, PG8_SP2>(lds, g2, S2, E2);
            if (mine) {
                asm volatile("s_waitcnt vmcnt(0)" ::: "memory"); __syncthreads();
                if (tid == 0) { __builtin_amdgcn_fence(__ATOMIC_RELEASE, "agent"); asm volatile("s_waitcnt vmcnt(0)" ::: "memory"); (void)xb_add(late, (unsigned)n_mine); }
                __syncthreads();
            }
        }
        bool late_ok = false;
        for (int rep = 0; rep < 1 + PROBE_REP5; ++rep) {
        unsigned* ctr = (unsigned*)(ws + WS_CTL) + 128 + 128 * rep;
        const int NL = G < 64 ? G : 64; const bool owner = (int)blockIdx.x < NL;
#define P5_NEXT() ({ const int n_ = queue_next(ctr, lds, tid); n_ < NL ? n_ : n_ - NL + G; })
        for (int it = owner ? P5_NEXT() : (int)blockIdx.x; it < 1024; it = P5_NEXT()) {
            if (it < 512) { const int bh = it & 31, qb = 15 - (it >> 5); unit_D(P, lds, bh, qb, tid, lane, wave); }
            else {
                const int r = it - 512, half = r >> 8, idx = r & 255, cc = 63 - (idx >> 2), bb = idx & 3;
                if (half && !late_ok) {
                    if (tid == 0) { unsigned sp = 0; while (xb_ld(late) < 64u) { __builtin_amdgcn_s_sleep(2); if (++sp > (1u << 22)) break; }
                        __builtin_amdgcn_fence(__ATOMIC_ACQUIRE, "agent"); asm volatile("s_waitcnt vmcnt(0)" ::: "memory"); }
                    __syncthreads(); late_ok = true;
                }
                unit_C(P, lds, bb, half, cc, tid, lane, wave);
            }
        }
        }
    }
    SEAM(5);
    if (IN(6)) {
        pg8::Gemm g{(const bf16*)(ws + WS_MIX), (const bf16*)(ws + WS_BTO1), M, DM, DM}; pg8::StaticOrder S; S.init(M, DM, G, (int)blockIdx.x);
        pg8::EpiOut E{nullptr, (const bf16*)(ws + WS_XB), P.out, nullptr, nullptr};
        pg8::gemm_phase<pg8::EpiOut, pg8::StaticOrder, false, PG8_SP2>(lds, g, S, E);
    }
#undef IN
#undef SEAM
}

extern "C" void kernel_launch(void* const* d_in, const int* in_sizes, int n_in, void* d_out, int out_size, void* d_ws, size_t ws_size, hipStream_t stream) {
    static int grid = 0;
    if (grid == 0) {
        if (n_in != 23 || out_size != M * DM || ws_size < WS_END) { fprintf(stderr, "kernel_launch: unexpected shapes (n_in %d, out %d, ws %zu)\n", n_in, out_size, ws_size); grid = -1; return; }
        int dev = 0, cus = 0, per_cu = 0;
        hipGetDevice(&dev); hipDeviceGetAttribute(&cus, hipDeviceAttributeMultiprocessorCount, dev);
        if (hipFuncSetAttribute((const void*)trunk_fwd, hipFuncAttributeMaxDynamicSharedMemorySize, LDS_BYTES) != hipSuccess) { fprintf(stderr, "kernel_launch: hipFuncSetAttribute failed\n"); grid = -1; return; }
        if (hipOccupancyMaxActiveBlocksPerMultiprocessor(&per_cu, (const void*)trunk_fwd, NTHR, LDS_BYTES) != hipSuccess || per_cu < 1) { fprintf(stderr, "kernel_launch: occupancy query says %d\n", per_cu); per_cu = 1; }
        (void)hipGetLastError();
        grid = cus * 1;
        if (grid <= 0) grid = 256;
    }
    if (grid < 0) return;
    if (hipMemsetAsync((char*)d_ws + WS_CTL, 0, 65536, stream) != hipSuccess) { fprintf(stderr, "kernel_launch: memset failed\n"); return; }
    Params p{};
    for (int i = 0; i < 23; ++i) p.in[i] = (const float*)d_in[i];
    p.out = (float*)d_out; p.ws = (unsigned char*)d_ws;
#if MK_LAUNCHES == 1
    p.ph_lo = 0; p.ph_hi = 7;
    void* args[] = {&p};
    hipError_t e = hipLaunchCooperativeKernel((const void*)trunk_fwd, dim3(grid), dim3(NTHR), args, LDS_BYTES, stream);
    if (e != hipSuccess) fprintf(stderr, "kernel_launch: cooperative launch failed: %s (grid %d)\n", hipGetErrorString(e), grid);
#else
    for (int ph = 0; ph < 7; ++ph) { p.ph_lo = ph; p.ph_hi = ph + 1; hipLaunchKernelGGL(trunk_fwd, dim3(grid), dim3(NTHR), LDS_BYTES, stream, p); }
#endif
}
```
